# Optimizing an MI355X kernel written in HIP

```python
import jax, jax.numpy as jnp
from jax import lax
import numpy as np

D_MODEL = 1024
BATCH = 8
SEQ = 2048
DEPTH = 1
DEC_BATCH = 128
DEC_SEQ = 1
PAST_LEN = 16384
PAGE_SIZE = 128

MIX_WIDTH = D_MODEL
POOL_WINDOWS = (2, 4, 8, 16)
POOL_GROUPS = len(POOL_WINDOWS)
POOL_WIDTH = MIX_WIDTH // 2
POOL_GC = POOL_WIDTH // POOL_GROUPS
POOL_HIST = max(POOL_WINDOWS) - 1
CONV_WIDTH = MIX_WIDTH - POOL_WIDTH
CONV_HEADS = 8
CONV_K = 3
IN_COLS = POOL_WIDTH + 3 * CONV_WIDTH
D_FF = 2816
PLE_DIM = 256
EPS = 1e-6

kernel_name = "hybrid_pool_shortconv_convffn_step"


def rmsnorm(x, g):
    x32 = x.astype(jnp.float32)
    y = x32 * lax.rsqrt(jnp.mean(x32 * x32, axis=-1, keepdims=True) + EPS)
    return (y * g.astype(jnp.float32)).astype(x.dtype)


def causal_dwconv(z, prev, w, b):
    T = z.shape[1]
    ext = jnp.concatenate([prev.astype(z.dtype), z], axis=1)
    y = sum(ext[:, k:k + T] * w[k] for k in range(CONV_K)) + b
    return y, ext[:, -(CONV_K - 1):]


def pool_mix(u, prev, pos, w_pool, scale):
    N, T, _ = u.shape
    ext = jnp.concatenate([prev.astype(u.dtype), u], axis=1)
    cs = jnp.cumsum(ext.astype(jnp.float32), axis=1)
    cs = jnp.concatenate([jnp.zeros((N, 1, POOL_WIDTH), jnp.float32), cs], axis=1)
    end = cs[:, POOL_HIST + 1:]
    means = []
    for g, w in enumerate(POOL_WINDOWS):
        sl = slice(g * POOL_GC, (g + 1) * POOL_GC)
        start = cs[:, POOL_HIST + 1 - w:POOL_HIST + 1 - w + T, sl]
        cnt = jnp.minimum(w, pos + 1).astype(jnp.float32)[None, :, None]
        means.append((end[..., sl] - start) / cnt)
    d = jnp.concatenate(means, axis=-1) - u.astype(jnp.float32)
    d = d.astype(u.dtype).reshape(N, T, POOL_GROUPS, POOL_GC)
    y = jnp.einsum('ntgc,gcd->ntgd', d, w_pool).reshape(N, T, POOL_WIDTH) * scale
    return y, ext[:, -POOL_HIST:]


def layer(r, p, pool_prev, conv_prev, ffn_prev, pos,
          g_mix, w_in, w_pool, pool_scale, conv_w, conv_b, w_out,
          g_ffn, w_up, ffn_conv_w, ffn_conv_b, w_down, g_ple, w_ple_gate, w_ple_proj):
    h = rmsnorm(r, g_mix)
    proj = h @ w_in
    u = proj[..., :POOL_WIDTH]
    bg, cg, hv = jnp.split(proj[..., POOL_WIDTH:], 3, axis=-1)
    y_pool, pool_new = pool_mix(u, pool_prev, pos, w_pool, pool_scale)
    conv_y, conv_new = causal_dwconv(cg * hv, conv_prev, conv_w, conv_b)
    y_conv = bg * conv_y
    r = r + jnp.concatenate([y_pool, y_conv], axis=-1) @ w_out
    h2 = rmsnorm(r, g_ffn)
    up, ffn_new = causal_dwconv(h2 @ w_up, ffn_prev, ffn_conv_w, ffn_conv_b)
    a, v = jnp.split(up, 2, axis=-1)
    r = r + (jax.nn.silu(a) * v) @ w_down
    gate = jax.nn.sigmoid(rmsnorm(r, g_ple) @ w_ple_gate)
    r = r + gate * (p @ w_ple_proj)
    return r, pool_new, conv_new, ffn_new


def setup_inputs(seed: int = 0) -> dict:
    key = jax.random.key(seed)
    ks = iter(jax.random.split(key, 32))
    f32 = jnp.float32
    nrm = lambda shape, s=1.0: (jax.random.normal(next(ks), shape, f32) * s)
    gain = lambda shape: 1.0 + 0.05 * jax.random.normal(next(ks), shape, f32)
    return {
        "x_prompt": nrm((BATCH, SEQ, D_MODEL)),
        "x_sample": nrm((DEC_BATCH, DEC_SEQ, D_MODEL)),
        "state_pool": nrm((DEPTH, DEC_BATCH, POOL_HIST, POOL_WIDTH)),
        "state_conv": nrm((DEPTH, DEC_BATCH, CONV_K - 1, CONV_WIDTH)),
        "state_ffn": nrm((DEPTH, DEC_BATCH, CONV_K - 1, 2 * D_FF)),
        "p_prompt": nrm((DEPTH, BATCH, SEQ, PLE_DIM)),
        "p_sample": nrm((DEPTH, DEC_BATCH, DEC_SEQ, PLE_DIM)),
        "g_mix": gain((DEPTH, D_MODEL)),
        "w_in": nrm((DEPTH, D_MODEL, IN_COLS), D_MODEL ** -0.5),
        "w_pool": nrm((DEPTH, POOL_GROUPS, POOL_GC, POOL_GC), POOL_GC ** -0.5),
        "pool_scale": gain((DEPTH, POOL_WIDTH)),
        "conv_w": nrm((DEPTH, CONV_K, CONV_WIDTH), CONV_K ** -0.5),
        "conv_b": nrm((DEPTH, CONV_WIDTH), 0.02),
        "w_out": nrm((DEPTH, MIX_WIDTH, D_MODEL), MIX_WIDTH ** -0.5),
        "g_ffn": gain((DEPTH, D_MODEL)),
        "w_up": nrm((DEPTH, D_MODEL, 2 * D_FF), D_MODEL ** -0.5),
        "ffn_conv_w": nrm((DEPTH, CONV_K, 2 * D_FF), CONV_K ** -0.5),
        "ffn_conv_b": nrm((DEPTH, 2 * D_FF), 0.02),
        "w_down": nrm((DEPTH, D_FF, D_MODEL), D_FF ** -0.5),
        "g_ple": gain((DEPTH, D_MODEL)),
        "w_ple_gate": nrm((DEPTH, D_MODEL, D_MODEL), D_MODEL ** -0.5),
        "w_ple_proj": nrm((DEPTH, PLE_DIM, D_MODEL), PLE_DIM ** -0.5),
        "g_final": gain((D_MODEL,)),
    }


def reference(x_prompt, x_sample, state_pool, state_conv, state_ffn, p_prompt, p_sample,
              g_mix, w_in, w_pool, pool_scale, conv_w, conv_b, w_out,
              g_ffn, w_up, ffn_conv_w, ffn_conv_b, w_down, g_ple, w_ple_gate, w_ple_proj, g_final):
    nb, tp = x_prompt.shape[0], x_prompt.shape[1]
    ts = x_sample.shape[1]
    pos_p = jnp.arange(tp, dtype=jnp.int32)
    pos_s = PAST_LEN + jnp.arange(ts, dtype=jnp.int32)
    dt = x_prompt.dtype
    rp, rs = x_prompt, x_sample
    pp_l, pc_l, pf_l, sp_l, sc_l, sf_l = [], [], [], [], [], []
    for i in range(DEPTH):
        w = (g_mix[i], w_in[i], w_pool[i], pool_scale[i], conv_w[i], conv_b[i], w_out[i],
             g_ffn[i], w_up[i], ffn_conv_w[i], ffn_conv_b[i], w_down[i],
             g_ple[i], w_ple_gate[i], w_ple_proj[i])
        rp, pp, pc, pf = layer(rp, p_prompt[i],
                               jnp.zeros((nb, POOL_HIST, POOL_WIDTH), dt),
                               jnp.zeros((nb, CONV_K - 1, CONV_WIDTH), dt),
                               jnp.zeros((nb, CONV_K - 1, 2 * D_FF), dt), pos_p, *w)
        rs, sp, sc, sf = layer(rs, p_sample[i], state_pool[i], state_conv[i], state_ffn[i], pos_s, *w)
        pp_l.append(pp); pc_l.append(pc); pf_l.append(pf)
        sp_l.append(sp); sc_l.append(sc); sf_l.append(sf)
    y_prompt = rmsnorm(rp, g_final)
    y_sample = rmsnorm(rs, g_final)
    return (y_prompt, y_sample,
            jnp.stack(pp_l), jnp.stack(pc_l), jnp.stack(pf_l),
            jnp.stack(sp_l), jnp.stack(sc_l), jnp.stack(sf_l))
```

```cpp
#include <hip/hip_runtime.h>
#include <hip/hip_cooperative_groups.h>
#include <cstdio>
#include <cstdint>
namespace cg = cooperative_groups;

#define LAS __attribute__((address_space(3)))
typedef unsigned short bf16_t;
typedef short bf16x8 __attribute__((ext_vector_type(8)));
typedef float f32x4 __attribute__((ext_vector_type(4)));
typedef unsigned u32x4 __attribute__((ext_vector_type(4)));
typedef unsigned u32x2 __attribute__((ext_vector_type(2)));

constexpr int DM = 1024, TP = 16384, TS = 128, MV = 16512, MPAD = 16640, NINC = 2048, DFF = 2816, NUP = 5632, PLE = 256;
constexpr float EPS = 1e-6f;
constexpr size_t O_Y = 0, O_PP = 16908288, O_CP = 16969728, O_FP = 16977920, O_PS = 17068032, O_CS = 18051072, O_FS = 18182144;
constexpr size_t MiB = 1u << 20;
constexpr size_t WS_WIN = 0, WS_WOUT = 4 * MiB, WS_WUP = 6 * MiB, WS_WDOWN = 17 * MiB, WS_WG = 22 * MiB + MiB / 2, WS_WP = 24 * MiB + MiB / 2, WS_WPOOL = 25 * MiB,
                 WS_RSTD1 = 25 * MiB + MiB / 4, WS_SSQ2 = 25 * MiB + MiB / 2, WS_SSQ3 = 27 * MiB, WS_UPB = 28 * MiB + MiB / 2, WS_RB = 35 * MiB,
                 WS_XB = 68 * MiB, WS_PROJ = 101 * MiB, WS_MIX = 166 * MiB, WS_ACT = 68 * MiB, WS_PP = 166 * MiB, WS_PB = 199 * MiB, WS_END = 208 * MiB;

struct Params {
    const float *x_prompt, *x_sample, *state_pool, *state_conv, *state_ffn, *p_prompt, *p_sample;
    const float *g_mix, *w_in, *w_pool, *pool_scale, *conv_w, *conv_b, *w_out, *g_ffn, *w_up, *ffn_conv_w, *ffn_conv_b, *w_down, *g_ple, *w_ple_gate, *w_ple_proj, *g_final;
    float* out; unsigned char* ws;
    int ph_lo, ph_hi;
};

__device__ __forceinline__ unsigned cvt_pk_bf16(float lo, float hi) { unsigned r; asm volatile("v_cvt_pk_bf16_f32 %0, %1, %2" : "=v"(r) : "v"(lo), "v"(hi)); return r; }
__device__ __forceinline__ float bf_lo(unsigned w) { return __uint_as_float(w << 16); }
__device__ __forceinline__ float bf_hi(unsigned w) { return __uint_as_float(w & 0xffff0000u); }
__device__ __forceinline__ float sigmoidf_(float x) { return __builtin_amdgcn_rcpf(1.0f + __expf(-x)); }

namespace pg8 {
constexpr int BM = 256, BK = 64, HALF = 128, HTB = HALF * BK * 2, STAGE_BYTES = 8 * HTB, NXCD = 8, WGM = 8;
__host__ __device__ __forceinline__ int lds_byte(int r, int c) { const int st = (r >> 4) * 2 + (c >> 5), rr = r & 15, cc = c & 31, ob = rr * 64 + cc * 2; return st * 1024 + (ob ^ (((ob >> 9) & 1) << 5)); }
__host__ __device__ __forceinline__ void stage_rc(int b, int& R, int& C) { const int st = b / 1024, sb = b % 1024, swz = sb ^ (((sb >> 9) & 1) << 5); R = (st >> 1) * 16 + swz / 64; C = (st & 1) * 32 + (swz % 64) / 2; }
__host__ __device__ __forceinline__ int perm32(int rho) { const int n = rho >> 4, i = rho & 15; return 8 * (i >> 2) + 4 * n + (i & 3); }
struct Unit { int pm, pn; };
struct Gemm { const bf16_t* A; const bf16_t* Bt; int M, N, K; };
struct StaticOrder {
    int nM, nN, nwg, G, c;
    int pm_off;
    __device__ void init(int M, int N, int G_, int c_, int pm_off_ = 0) { nM = M / BM; nN = N / BM; nwg = nM * nN; G = G_; c = c_; pm_off = pm_off_; }
    __device__ bool next(int i, Unit& u) const {
        const long L = (long)i * G + c; if (L >= nwg) return false;
        int wgid = (int)L; { const int q = nwg / NXCD, r = nwg % NXCD, xcd = wgid % NXCD, off = wgid / NXCD; wgid = (xcd < r ? xcd * (q + 1) : r * (q + 1) + (xcd - r) * q) + off; }
        const int nig = WGM * nN, gid = wgid / nig, fm = gid * WGM, gsz = (nM - fm) < WGM ? (nM - fm) : WGM;
        u.pm = pm_off + fm + ((wgid % nig) % gsz); u.pn = (wgid % nig) / gsz; return true;
    }
};

template <class Epi>
__device__ __forceinline__ void gemm_phase(LAS unsigned char* lds, const Gemm g, const StaticOrder& S, const Epi& E) {
    int tid_ = threadIdx.x; asm volatile("" : "+v"(tid_));
    const int tid = tid_, wid = __builtin_amdgcn_readfirstlane(tid >> 6), lane = tid & 63, wr = wid >> 2, wc = wid & 3, fr = lane & 15, fq = lane >> 4;
    const int K = g.K, nt = K / BK;
    unsigned voffA[2], voffB[2];
#pragma unroll
    for (int i = 0; i < 2; ++i) { int R, C; stage_rc(tid * 16 + i * 8192, R, C); const int Rb = Epi::PERM ? ((R & ~31) + perm32(R & 31)) : R;
        voffA[i] = (unsigned)(R * K + C) * 2u; voffB[i] = (unsigned)(Rb * K + C) * 2u; }
    const size_t kstep = (size_t)(BK * 2);
    const size_t hstep = (size_t)HALF * K * 2;
    const size_t tstep = 2 * hstep;
    const unsigned ldsw = (unsigned)wid * 1024u;
    const int aoff = lds_byte(wr * 64 + fr, fq * 8), boff = lds_byte(wc * 32 + fr, fq * 8);
#define PG8_SA(b, h) (((b) * 2 + (h)) * HTB)
#define PG8_SB(b, h) ((4 + (b) * 2 + (h)) * HTB)
#define PG8_STAGE(bufoff, gbase, voff) do { _Pragma("unroll") for (int _i = 0; _i < 2; ++_i) \
        __builtin_amdgcn_global_load_lds((const unsigned*)((const char*)(gbase) + (voff)[_i]), (LAS unsigned*)(lds + (bufoff) + ldsw + _i * 8192), 16, 0, 0); } while (0)
#define PG8_LDA(dst, b, h) do { _Pragma("unroll") for (int m = 0; m < 4; ++m) _Pragma("unroll") for (int k = 0; k < 2; ++k) dst[m][k] = *(const LAS bf16x8*)(lds + PG8_SA(b, h) + aoff + m * 2048 + k * 1024); } while (0)
#define PG8_LDB(dst, b, h) do { _Pragma("unroll") for (int n = 0; n < 2; ++n) _Pragma("unroll") for (int k = 0; k < 2; ++k) dst[n][k] = *(const LAS bf16x8*)(lds + PG8_SB(b, h) + boff + n * 2048 + k * 1024); } while (0)
#define PG8_MMA(ai, bj, At, Bt) do { __builtin_amdgcn_s_setprio(1); _Pragma("unroll") for (int m = 0; m < 4; ++m) _Pragma("unroll") for (int n = 0; n < 2; ++n) _Pragma("unroll") for (int k = 0; k < 2; ++k) \
        acc[ai][bj][m][n] = __builtin_amdgcn_mfma_f32_16x16x32_bf16(Bt[n][k], At[m][k], acc[ai][bj][m][n], 0, 0, 0); __builtin_amdgcn_s_setprio(0); } while (0)
#define PG8_WAIT_V(n) asm volatile("s_waitcnt vmcnt(" #n ")" ::: "memory")
#define PG8_WAIT_L(n) asm volatile("s_waitcnt lgkmcnt(" #n ")" ::: "memory")
#define PG8_BAR __builtin_amdgcn_s_barrier()
#define PG8_SCHED __builtin_amdgcn_sched_barrier(0)
    Unit cur, nxt; int ui = 0;
    if (!S.next(0, cur)) return;
    f32x4 acc[2][2][4][2];
#pragma unroll
    for (int a = 0; a < 2; ++a)
#pragma unroll
        for (int b = 0; b < 2; ++b)
#pragma unroll
            for (int m = 0; m < 4; ++m)
#pragma unroll
                for (int n = 0; n < 2; ++n) acc[a][b][m][n] = (f32x4){0.f, 0.f, 0.f, 0.f};
    bf16x8 At[4][2], B0[2][2], B1[2][2];
    const char* cA = (const char*)g.A + (size_t)cur.pm * tstep; const char* cB = (const char*)g.Bt + (size_t)cur.pn * tstep;
    PG8_STAGE(PG8_SB(0, 0), cB, voffB); PG8_STAGE(PG8_SB(0, 1), cB + hstep, voffB); PG8_STAGE(PG8_SA(0, 0), cA, voffA); PG8_STAGE(PG8_SA(0, 1), cA + hstep, voffA);
    if (wr == 1) PG8_BAR;
    PG8_WAIT_V(2); PG8_BAR;
    PG8_STAGE(PG8_SB(1, 0), cB + kstep, voffB); PG8_STAGE(PG8_SA(1, 0), cA + kstep, voffA); PG8_STAGE(PG8_SB(1, 1), cB + hstep + kstep, voffB);
    PG8_WAIT_V(6); PG8_BAR;
    for (;;) {
        const bool has_next = S.next(ui + 1, nxt);
        const char* nA = has_next ? (const char*)g.A + (size_t)nxt.pm * tstep : cA; const char* nB = has_next ? (const char*)g.Bt + (size_t)nxt.pn * tstep : cB;
        for (int t = 0; t < nt; t += 2) {
            const bool last = (t == nt - 2);
            const char* a1 = cA + (size_t)(t + 1) * kstep;
            const char* a2 = last ? nA : cA + (size_t)(t + 2) * kstep; const char* b2 = last ? nB : cB + (size_t)(t + 2) * kstep;
            const char* a3 = a2 + kstep; const char* b3 = b2 + kstep;
            PG8_LDB(B0, 0, 0); PG8_LDB(B1, 0, 1); PG8_SCHED; PG8_LDA(At, 0, 0); PG8_STAGE(PG8_SA(1, 1), a1 + hstep, voffA);
            PG8_WAIT_V(8); PG8_WAIT_L(0); PG8_BAR; PG8_MMA(0, 0, At, B0); PG8_MMA(0, 1, At, B1); PG8_BAR; PG8_SCHED;
            PG8_LDA(At, 0, 1); PG8_STAGE(PG8_SB(0, 0), b2, voffB); PG8_STAGE(PG8_SB(0, 1), b2 + hstep, voffB); PG8_STAGE(PG8_SA(0, 0), a2, voffA);
            PG8_WAIT_V(8); PG8_WAIT_L(0); PG8_BAR; PG8_MMA(1, 0, At, B0); PG8_MMA(1, 1, At, B1); PG8_BAR; PG8_SCHED;
            PG8_LDB(B0, 1, 0); PG8_LDB(B1, 1, 1); PG8_SCHED; PG8_LDA(At, 1, 0); PG8_STAGE(PG8_SA(0, 1), a2 + hstep, voffA);
            PG8_WAIT_V(8); PG8_WAIT_L(0); PG8_BAR; PG8_MMA(0, 0, At, B0); PG8_MMA(0, 1, At, B1); PG8_BAR; PG8_SCHED;
            PG8_LDA(At, 1, 1); PG8_STAGE(PG8_SB(1, 0), b3, voffB); PG8_STAGE(PG8_SB(1, 1), b3 + hstep, voffB); PG8_STAGE(PG8_SA(1, 0), a3, voffA);
            PG8_WAIT_V(8); PG8_WAIT_L(0); PG8_BAR; PG8_MMA(1, 0, At, B0); PG8_MMA(1, 1, At, B1); PG8_BAR; PG8_SCHED;
        }
        if (wr == 0) PG8_BAR;
        E(acc, cur, wr, wc, fr, fq, lds + STAGE_BYTES, lane);
        if (!has_next) break;
#pragma unroll
        for (int a = 0; a < 2; ++a)
#pragma unroll
            for (int b = 0; b < 2; ++b)
#pragma unroll
                for (int m = 0; m < 4; ++m)
#pragma unroll
                    for (int n = 0; n < 2; ++n) acc[a][b][m][n] = (f32x4){0.f, 0.f, 0.f, 0.f};
        cur = nxt; cA = nA; cB = nB; ++ui;
        if (wr == 1) PG8_BAR;
    }
    PG8_WAIT_V(0);
    PG8_BAR;
#undef PG8_SA
#undef PG8_SB
#undef PG8_STAGE
#undef PG8_LDA
#undef PG8_LDB
#undef PG8_MMA
#undef PG8_WAIT_V
#undef PG8_WAIT_L
#undef PG8_BAR
#undef PG8_SCHED
}
}
using pg8::Unit;

struct EpiScaleBf16 {
    static constexpr bool PERM = true;
    bf16_t* O; int ldc; const float* rstd;
    __device__ __forceinline__ void operator()(f32x4 (&acc)[2][2][4][2], const Unit& u, int wr, int wc, int fr, int fq, LAS unsigned char*, int) const {
        const int row0 = u.pm * 256 + wr * 64 + fr, col0 = u.pn * 256 + wc * 32 + 8 * fq;
#pragma unroll
        for (int ai = 0; ai < 2; ++ai)
#pragma unroll
            for (int m = 0; m < 4; ++m) { const int row = row0 + ai * 128 + m * 16; const float rs = rstd ? rstd[row] : 1.0f; bf16_t* rowp = O + (size_t)row * ldc + col0;
#pragma unroll
                for (int bj = 0; bj < 2; ++bj) { const f32x4 v0 = acc[ai][bj][m][0] * rs, v1 = acc[ai][bj][m][1] * rs;
                    u32x4 w; w.x = cvt_pk_bf16(v0[0], v0[1]); w.y = cvt_pk_bf16(v0[2], v0[3]); w.z = cvt_pk_bf16(v1[0], v1[1]); w.w = cvt_pk_bf16(v1[2], v1[3]);
                    *(u32x4*)(rowp + bj * 128) = w; } }
    }
};
struct EpiRes {
    static constexpr bool PERM = false;
    const float* base_p; const float* base_s;
    float* out; bf16_t* rb; float* ssq;
    __device__ __forceinline__ void operator()(f32x4 (&acc)[2][2][4][2], const Unit& u, int wr, int wc, int fr, int fq, LAS unsigned char*, int) const {
        const int row0 = u.pm * 256 + wr * 64 + fr, col0 = u.pn * 256 + wc * 32 + 4 * fq;
#pragma unroll
        for (int ai = 0; ai < 2; ++ai)
#pragma unroll
            for (int m = 0; m < 4; ++m) { const int row = row0 + ai * 128 + m * 16; const bool valid = row < MV;
                const float* bp = (row < TP) ? base_p + (size_t)row * DM : base_s + (size_t)(row - TP) * DM;
                float ss = 0.f;
#pragma unroll
                for (int bj = 0; bj < 2; ++bj)
#pragma unroll
                    for (int n = 0; n < 2; ++n) { const int c = col0 + bj * 128 + n * 16;
                        f32x4 b = (f32x4){0.f, 0.f, 0.f, 0.f}; if (valid) b = *(const f32x4*)(bp + c);
                        const f32x4 o = b + acc[ai][bj][m][n]; ss += (o[0] * o[0] + o[1] * o[1]) + (o[2] * o[2] + o[3] * o[3]);
                        if (valid) *(f32x4*)(out + (size_t)row * DM + c) = o;
                        u32x2 w; w.x = cvt_pk_bf16(o[0], o[1]); w.y = cvt_pk_bf16(o[2], o[3]); *(u32x2*)(rb + (size_t)row * DM + c) = w; }
                ss += __shfl_xor(ss, 16); ss += __shfl_xor(ss, 32);
                if (fq == 0) ssq[(size_t)row * 16 + u.pn * 4 + wc] = ss; }
    }
};
__device__ __forceinline__ float rstd_from_ssq(const float* ssq, int row) {
    const f32x4* s = (const f32x4*)(ssq + (size_t)row * 16); const f32x4 a = s[0], b = s[1], c = s[2], d = s[3];
    const float t = ((a[0] + a[1]) + (a[2] + a[3])) + ((b[0] + b[1]) + (b[2] + b[3])) + ((c[0] + c[1]) + (c[2] + c[3])) + ((d[0] + d[1]) + (d[2] + d[3]));
    return rsqrtf(t * (1.0f / DM) + EPS);
}
__device__ __forceinline__ float rstd_from_ssq4(const float* ssq, int row, int fq) {
    const f32x4 a = ((const f32x4*)(ssq + (size_t)row * 16))[fq];
    float t = (a[0] + a[1]) + (a[2] + a[3]); t += __shfl_xor(t, 16); t += __shfl_xor(t, 32);
    return rsqrtf(t * (1.0f / DM) + EPS);
}
struct EpiGate {
    static constexpr bool PERM = false;
    float* out; const bf16_t* pp; const float* ssq;
    __device__ __forceinline__ void operator()(f32x4 (&acc)[2][2][4][2], const Unit& u, int wr, int wc, int fr, int fq, LAS unsigned char*, int) const {
        const int row0 = u.pm * 256 + wr * 64 + fr, col0 = u.pn * 256 + wc * 32 + 4 * fq;
#pragma unroll
        for (int ai = 0; ai < 2; ++ai)
#pragma unroll
            for (int m = 0; m < 4; ++m) { const int row = row0 + ai * 128 + m * 16; const float rs = rstd_from_ssq4(ssq, row, fq); if (row >= MV) continue;
#pragma unroll
                for (int bj = 0; bj < 2; ++bj)
#pragma unroll
                    for (int n = 0; n < 2; ++n) { const int c = col0 + bj * 128 + n * 16; const size_t off = (size_t)row * DM + c;
                        const f32x4 r2 = *(const f32x4*)(out + off); const u32x2 pw = *(const u32x2*)(pp + off); const f32x4 a = acc[ai][bj][m][n] * rs;
                        f32x4 o; o[0] = r2[0] + sigmoidf_(a[0]) * bf_lo(pw.x); o[1] = r2[1] + sigmoidf_(a[1]) * bf_hi(pw.x); o[2] = r2[2] + sigmoidf_(a[2]) * bf_lo(pw.y); o[3] = r2[3] + sigmoidf_(a[3]) * bf_hi(pw.y);
                        *(f32x4*)(out + off) = o; } }
    }
};
template <bool SAMPLE> struct EpiUp {
    static constexpr bool PERM = false;
    const float* ssq; const float* cw; const float* cb; const float* st_ffn; float* new_ffn_s; bf16_t* act; float* upb;
    __device__ __forceinline__ void operator()(f32x4 (&acc)[2][2][4][2], const Unit& u, int wr, int wc, int fr, int fq, LAS unsigned char* ex, int lane) const {
        const int rowb = u.pm * 256 + wr * 64 + fr;
#pragma unroll
        for (int ai = 0; ai < 2; ++ai)
#pragma unroll
            for (int m = 0; m < 4; ++m) { const float rs = rstd_from_ssq4(ssq, rowb + ai * 128 + m * 16, fq);
#pragma unroll
                for (int bj = 0; bj < 2; ++bj)
#pragma unroll
                    for (int n = 0; n < 2; ++n) acc[ai][bj][m][n] = acc[ai][bj][m][n] * rs; }
        constexpr bool sample = SAMPLE;
        const int chl = u.pn * 128 + wc * 32 + 4 * fq;
        const int e16 = (wc * 4 + fq) * 16;
        if constexpr (!sample) {
            if (fr >= 14) {
#pragma unroll
                for (int ai = 0; ai < 2; ++ai) { const int slab = 2 * ai + wr;
#pragma unroll
                    for (int bj = 0; bj < 2; ++bj)
#pragma unroll
                        for (int n = 0; n < 2; ++n) *(LAS f32x4*)(ex + ((((slab * 2 + (fr - 14)) * 2 + bj) * 2 + n) * 256 + e16)) = acc[ai][bj][3][n]; }
                if (wr == 1) {
#pragma unroll
                    for (int bj = 0; bj < 2; ++bj)
#pragma unroll
                        for (int n = 0; n < 2; ++n) *(f32x4*)(upb + (size_t)(u.pm * 4 + 2 + (fr - 14)) * NUP + bj * DFF + chl + 16 * n) = acc[1][bj][3][n]; }
            }
            if (wr == 0 && fr < 2) {
#pragma unroll
                for (int bj = 0; bj < 2; ++bj)
#pragma unroll
                    for (int n = 0; n < 2; ++n) *(f32x4*)(upb + (size_t)(u.pm * 4 + fr) * NUP + bj * DFF + chl + 16 * n) = acc[0][bj][0][n]; }
        }
        asm volatile("s_waitcnt lgkmcnt(0)" ::: "memory"); __builtin_amdgcn_s_barrier(); asm volatile("" ::: "memory");
        const int src1 = (lane & 48) | ((fr + 15) & 15), src2 = (lane & 48) | ((fr + 14) & 15);
#define EPIUP_LOADW() f32x4 w0[2], w1[2], w2[2], bb[2]; _Pragma("unroll") for (int bj = 0; bj < 2; ++bj) { const int col = bj * DFF + chl + 16 * n; \
                w0[bj] = *(const f32x4*)(cw + col); w1[bj] = *(const f32x4*)(cw + NUP + col); w2[bj] = *(const f32x4*)(cw + 2 * NUP + col); bb[bj] = *(const f32x4*)(cb + col); }
        if constexpr (!sample) {
#pragma unroll
            for (int n = 0; n < 2; ++n) { EPIUP_LOADW();
#pragma unroll
                for (int ai = 0; ai < 2; ++ai) { const int slab = 2 * ai + wr;
                    f32x4 pv[2];
#pragma unroll
                    for (int bj = 0; bj < 2; ++bj) { pv[bj] = (f32x4){0.f, 0.f, 0.f, 0.f};
                        if (slab > 0 && fr >= 14) pv[bj] = *(const LAS f32x4*)(ex + (((((slab - 1) * 2 + (fr - 14)) * 2 + bj) * 2 + n) * 256 + e16)); }
#pragma unroll
                    for (int m = 0; m < 4; ++m) { f32x4 cv[2];
#pragma unroll
                        for (int bj = 0; bj < 2; ++bj) { const f32x4 prev = (m == 0) ? pv[bj] : acc[ai][bj][m == 0 ? 0 : m - 1][n]; const f32x4 cur = acc[ai][bj][m][n];
#pragma unroll
                            for (int i = 0; i < 4; ++i) { const float sa = (fr >= 14) ? prev[i] : cur[i], sb = (fr == 15) ? prev[i] : cur[i];
                                const float p2 = __shfl(sa, src2), p1 = __shfl(sb, src1);
                                cv[bj][i] = w0[bj][i] * p2 + w1[bj][i] * p1 + w2[bj][i] * cur[i] + bb[bj][i]; } }
                        float o[4];
#pragma unroll
                        for (int i = 0; i < 4; ++i) o[i] = cv[0][i] * sigmoidf_(cv[0][i]) * cv[1][i];
                        u32x2 w; w.x = cvt_pk_bf16(o[0], o[1]); w.y = cvt_pk_bf16(o[2], o[3]);
                        *(u32x2*)(act + (size_t)(rowb + ai * 128 + m * 16) * DFF + chl + 16 * n) = w; __builtin_amdgcn_sched_barrier(0); } }
            }
        } else {
#pragma unroll
            for (int n = 0; n < 2; ++n) { EPIUP_LOADW();
#pragma unroll
                for (int m = 0; m < 4; ++m) { const int rn = wr * 64 + m * 16 + fr; f32x4 cv[2];
#pragma unroll
                    for (int bj = 0; bj < 2; ++bj) { const int col = bj * DFF + chl + 16 * n;
                        const f32x4 p2 = *(const f32x4*)(st_ffn + (size_t)(rn * 2) * NUP + col), p1 = *(const f32x4*)(st_ffn + (size_t)(rn * 2 + 1) * NUP + col), cur = acc[0][bj][m][n];
                        cv[bj] = w0[bj] * p2 + w1[bj] * p1 + w2[bj] * cur + bb[bj];
                        *(f32x4*)(new_ffn_s + (size_t)(rn * 2) * NUP + col) = p1; *(f32x4*)(new_ffn_s + (size_t)(rn * 2 + 1) * NUP + col) = cur; }
                    float o[4];
#pragma unroll
                    for (int i = 0; i < 4; ++i) o[i] = cv[0][i] * sigmoidf_(cv[0][i]) * cv[1][i];
                    u32x2 w; w.x = cvt_pk_bf16(o[0], o[1]); w.y = cvt_pk_bf16(o[2], o[3]);
                    *(u32x2*)(act + (size_t)(TP + rn) * DFF + chl + 16 * n) = w; __builtin_amdgcn_sched_barrier(0); }
            }
        }
#undef EPIUP_LOADW
    }
};

__device__ __forceinline__ float wave_sum(float v) {
#pragma unroll
    for (int o = 1; o < 64; o <<= 1) v += __shfl_xor(v, o);
    return v;
}
__device__ __forceinline__ void transpose_item(const float* W, int K, int Nsrc, int k0, int oc0, const float* gk, bf16_t* WT, int orow0, LAS float* scr, int lane) {
#pragma unroll 8
    for (int i = 0; i < 32; ++i) { const int kk = 2 * i + (lane >> 5); float v = W[(size_t)(k0 + kk) * Nsrc + oc0 + (lane & 31)]; if (gk) v *= gk[k0 + kk]; scr[kk * 33 + (lane & 31)] = v; }
    asm volatile("s_waitcnt lgkmcnt(0)" ::: "memory");
    const int c = lane & 7;
#pragma unroll
    for (int j = 0; j < 4; ++j) { const int n = (lane >> 3) + 8 * j; const LAS float* s = scr + (8 * c) * 33 + n;
        u32x4 o; o.x = cvt_pk_bf16(s[0 * 33], s[1 * 33]); o.y = cvt_pk_bf16(s[2 * 33], s[3 * 33]); o.z = cvt_pk_bf16(s[4 * 33], s[5 * 33]); o.w = cvt_pk_bf16(s[6 * 33], s[7 * 33]);
        *(u32x4*)(WT + (size_t)(orow0 + n) * K + k0 + 8 * c) = o; }
    asm volatile("s_waitcnt lgkmcnt(0)" ::: "memory");
}
__device__ __forceinline__ void p0_prep(const Params& P, LAS unsigned char* lds) {
    const int tid = threadIdx.x, lane = tid & 63, wave = tid >> 6;
    const int gw = blockIdx.x * 8 + wave, NGW = gridDim.x * 8;
    unsigned char* ws = P.ws;
    LAS float* scr = (LAS float*)(lds + wave * 8704);
    constexpr int I_IN = 16 * 64, I_OUT = 16 * 32, I_UP = 16 * 176, I_DN = 44 * 32, I_G = 16 * 32, I_P = 4 * 32, I_PL = 4 * 2 * 4;
    constexpr int NIT = I_IN + I_OUT + I_UP + I_DN + I_G + I_P + I_PL;
    for (int it = gw; it < NIT; it += NGW) {
        int r = it;
        if (r < I_IN) { const int kb = r / 64, nb = r % 64; transpose_item(P.w_in, DM, NINC, 64 * kb, 32 * nb, P.g_mix, (bf16_t*)(ws + WS_WIN), 32 * nb, scr, lane); continue; } r -= I_IN;
        if (r < I_OUT) { const int kb = r / 32, nb = r % 32; transpose_item(P.w_out, DM, DM, 64 * kb, 32 * nb, nullptr, (bf16_t*)(ws + WS_WOUT), 32 * nb, scr, lane); continue; } r -= I_OUT;
        if (r < I_UP) { const int kb = r / 176, nb = r % 176; const int c = 32 * nb; const int oc = ((c & 255) >= 128 ? DFF : 0) + 128 * (c >> 8) + (c & 127);
            transpose_item(P.w_up, DM, NUP, 64 * kb, oc, P.g_ffn, (bf16_t*)(ws + WS_WUP), c, scr, lane); continue; } r -= I_UP;
        if (r < I_DN) { const int kb = r / 32, nb = r % 32; transpose_item(P.w_down, DFF, DM, 64 * kb, 32 * nb, nullptr, (bf16_t*)(ws + WS_WDOWN), 32 * nb, scr, lane); continue; } r -= I_DN;
        if (r < I_G) { const int kb = r / 32, nb = r % 32; transpose_item(P.w_ple_gate, DM, DM, 64 * kb, 32 * nb, P.g_ple, (bf16_t*)(ws + WS_WG), 32 * nb, scr, lane); continue; } r -= I_G;
        if (r < I_P) { const int kb = r / 32, nb = r % 32; transpose_item(P.w_ple_proj, PLE, DM, 64 * kb, 32 * nb, nullptr, (bf16_t*)(ws + WS_WP), 32 * nb, scr, lane); continue; } r -= I_P;
        { const int gI = r / 8, q = r % 8, kb = q / 4, nb = q % 4; transpose_item(P.w_pool + (size_t)gI * 128 * 128, 128, 128, 64 * kb, 32 * nb, nullptr, (bf16_t*)(ws + WS_WPOOL) + (size_t)gI * 128 * 128, 32 * nb, scr, lane); }
    }
    bf16_t* XB = (bf16_t*)(ws + WS_XB); float* RSTD1 = (float*)(ws + WS_RSTD1);
    for (int row = gw; row < MPAD; row += NGW) {
        unsigned long long* o8 = (unsigned long long*)(XB + (size_t)row * DM) + lane;
        if (row < MV) {
            const float* xr = (row < TP) ? P.x_prompt + (size_t)row * DM : P.x_sample + (size_t)(row - TP) * DM;
            const f32x4* x4 = (const f32x4*)xr + lane; f32x4 v[4]; float s = 0.f;
#pragma unroll
            for (int j = 0; j < 4; ++j) { v[j] = x4[64 * j]; s += (v[j][0] * v[j][0] + v[j][1] * v[j][1]) + (v[j][2] * v[j][2] + v[j][3] * v[j][3]); }
            s = wave_sum(s);
            if (lane == 0) RSTD1[row] = rsqrtf(s * (1.0f / DM) + EPS);
#pragma unroll
            for (int j = 0; j < 4; ++j) o8[64 * j] = (unsigned long long)cvt_pk_bf16(v[j][0], v[j][1]) | ((unsigned long long)cvt_pk_bf16(v[j][2], v[j][3]) << 32);
        } else {
#pragma unroll
            for (int j = 0; j < 4; ++j) o8[64 * j] = 0ull;
            if (lane == 0) RSTD1[row] = 0.f;
        }
    }
    bf16_t* PB = (bf16_t*)(ws + WS_PB);
    const int gt = blockIdx.x * 512 + tid, NGT = gridDim.x * 512;
    for (int i = gt; i < MPAD * 64; i += NGT) { const int row = i >> 6, c4 = (i & 63) * 4; u32x2 w; w.x = 0u; w.y = 0u;
        if (row < MV) { const float* pr = (row < TP) ? P.p_prompt + (size_t)row * PLE : P.p_sample + (size_t)(row - TP) * PLE; const f32x4 v = *(const f32x4*)(pr + c4); w.x = cvt_pk_bf16(v[0], v[1]); w.y = cvt_pk_bf16(v[2], v[3]); }
        *(u32x2*)(PB + (size_t)row * PLE + c4) = w; }
}

__device__ __forceinline__ void unpack8(const u32x4 w, float (&f)[8]) { f[0] = bf_lo(w.x); f[1] = bf_hi(w.x); f[2] = bf_lo(w.y); f[3] = bf_hi(w.y); f[4] = bf_lo(w.z); f[5] = bf_hi(w.z); f[6] = bf_lo(w.w); f[7] = bf_hi(w.w); }
__device__ __forceinline__ void p2_mix(const Params& P, LAS unsigned char* lds) {
    const int tid = threadIdx.x, lane = tid & 63, wave = tid >> 6, fr = lane & 15, fq = lane >> 4;
    unsigned char* ws = P.ws;
    const bf16_t* PROJ = (const bf16_t*)(ws + WS_PROJ); bf16_t* MIX = (bf16_t*)(ws + WS_MIX); const bf16_t* WPT = (const bf16_t*)(ws + WS_WPOOL);
    float* out = P.out;
    {
        const int gt = blockIdx.x * 512 + tid, NGT = gridDim.x * 512;
        for (int i = gt; i < MV * 64; i += NGT) { const int row = i >> 6, c8 = (i & 63) * 8;
            float w0[8], w1[8], w2[8], bb[8];
#pragma unroll
            for (int h = 0; h < 2; ++h) { const f32x4 a = *(const f32x4*)(P.conv_w + c8 + 4 * h), b = *(const f32x4*)(P.conv_w + 512 + c8 + 4 * h), c = *(const f32x4*)(P.conv_w + 1024 + c8 + 4 * h), d = *(const f32x4*)(P.conv_b + c8 + 4 * h);
#pragma unroll
                for (int e = 0; e < 4; ++e) { w0[4 * h + e] = a[e]; w1[4 * h + e] = b[e]; w2[4 * h + e] = c[e]; bb[4 * h + e] = d[e]; } }
            const bf16_t* pr = PROJ + (size_t)row * NINC;
            float bg[8], cg[8], hv[8], z0[8], z1[8], z2[8];
            unpack8(*(const u32x4*)(pr + 512 + c8), bg); unpack8(*(const u32x4*)(pr + 1024 + c8), cg); unpack8(*(const u32x4*)(pr + 1536 + c8), hv);
#pragma unroll
            for (int e = 0; e < 8; ++e) { z0[e] = cg[e] * hv[e]; z1[e] = 0.f; z2[e] = 0.f; }
            if (row < TP) { const int tl = row & 2047;
                if (tl >= 1) { unpack8(*(const u32x4*)(pr - NINC + 1024 + c8), cg); unpack8(*(const u32x4*)(pr - NINC + 1536 + c8), hv);
#pragma unroll
                    for (int e = 0; e < 8; ++e) z1[e] = cg[e] * hv[e]; }
                if (tl >= 2) { unpack8(*(const u32x4*)(pr - 2 * NINC + 1024 + c8), cg); unpack8(*(const u32x4*)(pr - 2 * NINC + 1536 + c8), hv);
#pragma unroll
                    for (int e = 0; e < 8; ++e) z2[e] = cg[e] * hv[e]; }
                if (tl >= 2046) { float* o = out + O_CP + (size_t)((row >> 11) * 2 + (tl - 2046)) * 512 + c8;
                    *(f32x4*)o = (f32x4){z0[0], z0[1], z0[2], z0[3]}; *(f32x4*)(o + 4) = (f32x4){z0[4], z0[5], z0[6], z0[7]}; }
            } else { const int n = row - TP; const float* sc = P.state_conv + (size_t)(n * 2) * 512 + c8;
                const f32x4 a0 = *(const f32x4*)sc, a1 = *(const f32x4*)(sc + 4), b0 = *(const f32x4*)(sc + 512), b1 = *(const f32x4*)(sc + 516);
#pragma unroll
                for (int e = 0; e < 4; ++e) { z2[e] = a0[e]; z2[4 + e] = a1[e]; z1[e] = b0[e]; z1[4 + e] = b1[e]; }
                float* o = out + O_CS + (size_t)(n * 2) * 512 + c8;
                *(f32x4*)o = b0; *(f32x4*)(o + 4) = b1; *(f32x4*)(o + 512) = (f32x4){z0[0], z0[1], z0[2], z0[3]}; *(f32x4*)(o + 516) = (f32x4){z0[4], z0[5], z0[6], z0[7]}; }
            float y[8];
#pragma unroll
            for (int e = 0; e < 8; ++e) y[e] = bg[e] * (w0[e] * z2[e] + w1[e] * z1[e] + w2[e] * z0[e] + bb[e]);
            u32x4 w; w.x = cvt_pk_bf16(y[0], y[1]); w.y = cvt_pk_bf16(y[2], y[3]); w.z = cvt_pk_bf16(y[4], y[5]); w.w = cvt_pk_bf16(y[6], y[7]);
            *(u32x4*)(MIX + (size_t)row * DM + 512 + c8) = w; }
    }
    LAS bf16_t* U = (LAS bf16_t*)lds;
    LAS bf16_t* Dm = (LAS bf16_t*)(lds + 36864);
    for (int item = blockIdx.x; item < 129 * 4; item += gridDim.x) {
        const int ti = item >> 2, g = item & 3, w = 2 << g, t0 = ti * 128;
        const int ch8 = tid & 15, rg = tid >> 4;
        if (ti < 128) {
            const bool has_halo = (t0 & 2047) != 0;
            for (int c = tid; c < 143 * 16; c += 512) { const int r = c >> 4, ch = c & 15; u32x4 v = (u32x4){0u, 0u, 0u, 0u};
                if (r >= 15 || has_halo) v = *(const u32x4*)(PROJ + (size_t)(t0 - 15 + r) * NINC + g * 128 + ch * 8);
                *(LAS u32x4*)(U + r * 128 + ch * 8) = v; }
            __syncthreads();
#pragma unroll 1
            for (int rr = 0; rr < 4; ++rr) { const int r = 4 * rg + rr, tl = (t0 + r) & 2047; const int cnt = (tl + 1 < w) ? tl + 1 : w;
                float s[8], cur[8], t8[8];
#pragma unroll
                for (int e = 0; e < 8; ++e) s[e] = 0.f;
                for (int i = 0; i < w; ++i) { unpack8(*(const LAS u32x4*)(U + (15 + r - i) * 128 + ch8 * 8), t8);
#pragma unroll
                    for (int e = 0; e < 8; ++e) s[e] += t8[e]; }
                unpack8(*(const LAS u32x4*)(U + (15 + r) * 128 + ch8 * 8), cur);
                const float inv = 1.0f / (float)cnt; float d[8];
#pragma unroll
                for (int e = 0; e < 8; ++e) d[e] = s[e] * inv - cur[e];
                u32x4 o; o.x = cvt_pk_bf16(d[0], d[1]); o.y = cvt_pk_bf16(d[2], d[3]); o.z = cvt_pk_bf16(d[4], d[5]); o.w = cvt_pk_bf16(d[6], d[7]);
                *(LAS u32x4*)(Dm + r * 136 + ch8 * 8) = o;
                if ((ti & 15) == 15 && r >= 113) { float* o2 = out + O_PP + (size_t)((ti >> 4) * 15 + (r - 113)) * 512 + g * 128 + ch8 * 8;
                    *(f32x4*)o2 = (f32x4){cur[0], cur[1], cur[2], cur[3]}; *(f32x4*)(o2 + 4) = (f32x4){cur[4], cur[5], cur[6], cur[7]}; } }
        } else {
#pragma unroll 1
            for (int rr = 0; rr < 4; ++rr) { const int n = 4 * rg + rr; float cur[8], s[8];
                unpack8(*(const u32x4*)(PROJ + (size_t)(TP + n) * NINC + g * 128 + ch8 * 8), cur);
#pragma unroll
                for (int e = 0; e < 8; ++e) s[e] = cur[e];
                const float* sp = P.state_pool + (size_t)n * 15 * 512 + g * 128 + ch8 * 8;
                for (int i = 1; i < w; ++i) { const f32x4 a = *(const f32x4*)(sp + (size_t)(15 - i) * 512), b = *(const f32x4*)(sp + (size_t)(15 - i) * 512 + 4);
#pragma unroll
                    for (int e = 0; e < 4; ++e) { s[e] += a[e]; s[4 + e] += b[e]; } }
                const float inv = 1.0f / (float)w; float d[8];
#pragma unroll
                for (int e = 0; e < 8; ++e) d[e] = s[e] * inv - cur[e];
                u32x4 o; o.x = cvt_pk_bf16(d[0], d[1]); o.y = cvt_pk_bf16(d[2], d[3]); o.z = cvt_pk_bf16(d[4], d[5]); o.w = cvt_pk_bf16(d[6], d[7]);
                *(LAS u32x4*)(Dm + n * 136 + ch8 * 8) = o;
                float* o2 = out + O_PS + (size_t)n * 15 * 512 + g * 128 + ch8 * 8;
                for (int i = 0; i < 14; ++i) { *(f32x4*)(o2 + (size_t)i * 512) = *(const f32x4*)(sp + (size_t)(i + 1) * 512); *(f32x4*)(o2 + (size_t)i * 512 + 4) = *(const f32x4*)(sp + (size_t)(i + 1) * 512 + 4); }
                *(f32x4*)(o2 + 14 * 512) = (f32x4){cur[0], cur[1], cur[2], cur[3]}; *(f32x4*)(o2 + 14 * 512 + 4) = (f32x4){cur[4], cur[5], cur[6], cur[7]}; }
        }
        __syncthreads();
        f32x4 acc[8];
#pragma unroll
        for (int nt = 0; nt < 8; ++nt) acc[nt] = (f32x4){0.f, 0.f, 0.f, 0.f};
#pragma unroll
        for (int kk = 0; kk < 4; ++kk) { const bf16x8 bfr = *(const LAS bf16x8*)(Dm + (16 * wave + fr) * 136 + 32 * kk + 8 * fq);
#pragma unroll
            for (int nt = 0; nt < 8; ++nt) { const bf16x8 afr = *(const bf16x8*)(WPT + (size_t)(g * 128 + 16 * nt + fr) * 128 + 32 * kk + 8 * fq);
                acc[nt] = __builtin_amdgcn_mfma_f32_16x16x32_bf16(afr, bfr, acc[nt], 0, 0, 0); } }
        const int row = t0 + 16 * wave + fr;
#pragma unroll
        for (int nt = 0; nt < 8; ++nt) { const int col = g * 128 + 16 * nt + 4 * fq; const f32x4 sc = *(const f32x4*)(P.pool_scale + col); const f32x4 o = acc[nt] * sc;
            u32x2 wv; wv.x = cvt_pk_bf16(o[0], o[1]); wv.y = cvt_pk_bf16(o[2], o[3]); *(u32x2*)(MIX + (size_t)row * DM + col) = wv; }
        __syncthreads();
    }
}

__device__ __forceinline__ void p4b_fix(const Params& P) {
    unsigned char* ws = P.ws; const float* upb = (const float*)(ws + WS_UPB); bf16_t* act = (bf16_t*)(ws + WS_ACT);
    const int gt = blockIdx.x * 512 + threadIdx.x, NGT = gridDim.x * 512;
    for (int i = gt; i < 64 * 2 * DFF; i += NGT) { const int ch = i % DFF, pr = i / DFF, pm = pr >> 1, r = pr & 1; const bool first = (pm & 7) == 0;
        float cv[2];
#pragma unroll
        for (int bj = 0; bj < 2; ++bj) { const int col = bj * DFF + ch; float p2, p1, cur;
            const float a0 = upb[(size_t)(pm * 4 + 0) * NUP + col];
            if (r == 0) { cur = a0; p1 = first ? 0.f : upb[(size_t)((pm - 1) * 4 + 3) * NUP + col]; p2 = first ? 0.f : upb[(size_t)((pm - 1) * 4 + 2) * NUP + col]; }
            else { cur = upb[(size_t)(pm * 4 + 1) * NUP + col]; p1 = a0; p2 = first ? 0.f : upb[(size_t)((pm - 1) * 4 + 3) * NUP + col]; }
            cv[bj] = P.ffn_conv_w[col] * p2 + P.ffn_conv_w[NUP + col] * p1 + P.ffn_conv_w[2 * NUP + col] * cur + P.ffn_conv_b[col]; }
        const float o = cv[0] * sigmoidf_(cv[0]) * cv[1];
        act[(size_t)(pm * 256 + r) * DFF + ch] = (bf16_t)(cvt_pk_bf16(o, 0.f) & 0xffffu); }
    for (int i = gt; i < 8 * 2 * NUP; i += NGT) { const int col = i % NUP, bj2 = i / NUP, b = bj2 >> 1, j = bj2 & 1;
        P.out[O_FP + i] = upb[(size_t)((8 * b + 7) * 4 + 2 + j) * NUP + col]; }
}

__device__ __forceinline__ void p7_final(const Params& P) {
    const int lane = threadIdx.x & 63, gw = blockIdx.x * 8 + (threadIdx.x >> 6), NGW = gridDim.x * 8;
    f32x4 gf[4];
#pragma unroll
    for (int j = 0; j < 4; ++j) gf[j] = ((const f32x4*)P.g_final)[64 * j + lane];
    for (int row = gw; row < MV; row += NGW) { f32x4* x4 = (f32x4*)(P.out + (size_t)row * DM) + lane; f32x4 v[4]; float s = 0.f;
#pragma unroll
        for (int j = 0; j < 4; ++j) { v[j] = x4[64 * j]; s += (v[j][0] * v[j][0] + v[j][1] * v[j][1]) + (v[j][2] * v[j][2] + v[j][3] * v[j][3]); }
        const float rs = rsqrtf(wave_sum(s) * (1.0f / DM) + EPS);
#pragma unroll
        for (int j = 0; j < 4; ++j) x4[64 * j] = v[j] * rs * gf[j]; }
}

constexpr int LDS_BYTES = pg8::STAGE_BYTES + 8192;

__global__ void __launch_bounds__(512, 2) fwd_kernel(Params P) {
    extern __shared__ __attribute__((aligned(16))) unsigned char lds_raw[];
    LAS unsigned char* lds = (LAS unsigned char*)lds_raw;
    cg::grid_group grid = cg::this_grid();
    unsigned char* ws = P.ws;
    const int lo = P.ph_lo, hi = P.ph_hi;
#define IN(k) (lo <= (k) && (k) < hi)
#define SEAM(k) do { if (IN(k) && IN((k) + 1)) grid.sync(); } while (0)
    const int G = gridDim.x, bx = blockIdx.x;
    bf16_t* RB = (bf16_t*)(ws + WS_RB);
    if (IN(0)) p0_prep(P, lds);
    SEAM(0);
    if (IN(1)) { pg8::Gemm g{(const bf16_t*)(ws + WS_XB), (const bf16_t*)(ws + WS_WIN), MPAD, NINC, DM}; pg8::StaticOrder S; S.init(MPAD, NINC, G, bx);
        EpiScaleBf16 E{(bf16_t*)(ws + WS_PROJ), NINC, (const float*)(ws + WS_RSTD1)}; pg8::gemm_phase(lds, g, S, E); }
    SEAM(1);
    if (IN(2)) p2_mix(P, lds);
    SEAM(2);
    if (IN(3)) { pg8::Gemm g{(const bf16_t*)(ws + WS_MIX), (const bf16_t*)(ws + WS_WOUT), MPAD, DM, DM}; pg8::StaticOrder S; S.init(MPAD, DM, G, bx);
        EpiRes E{P.x_prompt, P.x_sample, P.out, RB, (float*)(ws + WS_SSQ2)}; pg8::gemm_phase(lds, g, S, E); }
    SEAM(3);
    if (IN(4)) { pg8::Gemm g{RB, (const bf16_t*)(ws + WS_WUP), MPAD, NUP, DM};
        { pg8::StaticOrder S; S.init(TP, NUP, G, bx);
          EpiUp<false> E{(const float*)(ws + WS_SSQ2), P.ffn_conv_w, P.ffn_conv_b, P.state_ffn, P.out + O_FS, (bf16_t*)(ws + WS_ACT), (float*)(ws + WS_UPB)}; pg8::gemm_phase(lds, g, S, E); }
        { pg8::StaticOrder S; S.init(256, NUP, G, (bx + G / 2) % G, 64);
          EpiUp<true> E{(const float*)(ws + WS_SSQ2), P.ffn_conv_w, P.ffn_conv_b, P.state_ffn, P.out + O_FS, (bf16_t*)(ws + WS_ACT), (float*)(ws + WS_UPB)}; pg8::gemm_phase(lds, g, S, E); } }
    SEAM(4);
    if (IN(5)) p4b_fix(P);
    SEAM(5);
    if (IN(6)) {
        { pg8::Gemm g{(const bf16_t*)(ws + WS_ACT), (const bf16_t*)(ws + WS_WDOWN), MPAD, DM, DFF}; pg8::StaticOrder S; S.init(MPAD, DM, G, bx);
          EpiRes E{P.out, P.out + (size_t)TP * DM, P.out, RB, (float*)(ws + WS_SSQ3)}; pg8::gemm_phase(lds, g, S, E); }
        { pg8::Gemm g{(const bf16_t*)(ws + WS_PB), (const bf16_t*)(ws + WS_WP), MPAD, DM, PLE}; pg8::StaticOrder S; S.init(MPAD, DM, G, bx);
          EpiScaleBf16 E{(bf16_t*)(ws + WS_PP), DM, nullptr}; pg8::gemm_phase(lds, g, S, E); }
    }
    SEAM(6);
    if (IN(7)) { pg8::Gemm g{RB, (const bf16_t*)(ws + WS_WG), MPAD, DM, DM}; pg8::StaticOrder S; S.init(MPAD, DM, G, bx);
        EpiGate E{P.out, (const bf16_t*)(ws + WS_PP), (const float*)(ws + WS_SSQ3)}; pg8::gemm_phase(lds, g, S, E); }
    SEAM(7);
    if (IN(8)) p7_final(P);
#undef IN
#undef SEAM
}

extern "C" void kernel_launch(void* const* d_in, const int* in_sizes, int n_in, void* d_out, int out_size, void* d_ws, size_t ws_size, hipStream_t stream) {
    static int grid = 0;
    if (grid == 0) {
        int dev = 0, cus = 0, per_cu = 0;
        hipGetDevice(&dev);
        hipDeviceGetAttribute(&cus, hipDeviceAttributeMultiprocessorCount, dev);
        if (hipFuncSetAttribute((const void*)fwd_kernel, hipFuncAttributeMaxDynamicSharedMemorySize, LDS_BYTES) != hipSuccess) fprintf(stderr, "kernel_launch: hipFuncSetAttribute failed\n");
        if (hipOccupancyMaxActiveBlocksPerMultiprocessor(&per_cu, (const void*)fwd_kernel, 512, LDS_BYTES) != hipSuccess || per_cu < 1) { fprintf(stderr, "kernel_launch: occupancy query says %d\n", per_cu); per_cu = 1; }
        (void)hipGetLastError();
        grid = cus;
        if (ws_size < WS_END) fprintf(stderr, "kernel_launch: workspace too small: %zu < %zu\n", ws_size, (size_t)WS_END);
    }
    Params p{};
    const float* const* in = (const float* const*)d_in;
    p.x_prompt = in[0]; p.x_sample = in[1]; p.state_pool = in[2]; p.state_conv = in[3]; p.state_ffn = in[4]; p.p_prompt = in[5]; p.p_sample = in[6];
    p.g_mix = in[7]; p.w_in = in[8]; p.w_pool = in[9]; p.pool_scale = in[10]; p.conv_w = in[11]; p.conv_b = in[12]; p.w_out = in[13]; p.g_ffn = in[14]; p.w_up = in[15];
    p.ffn_conv_w = in[16]; p.ffn_conv_b = in[17]; p.w_down = in[18]; p.g_ple = in[19]; p.w_ple_gate = in[20]; p.w_ple_proj = in[21]; p.g_final = in[22];
    p.out = (float*)d_out; p.ws = (unsigned char*)d_ws; p.ph_lo = 0; p.ph_hi = 9;
    void* args[] = {&p};
    hipError_t e = hipLaunchCooperativeKernel((const void*)fwd_kernel, dim3(grid), dim3(512), args, LDS_BYTES, stream);
    if (e != hipSuccess) fprintf(stderr, "cooperative launch failed: %s (grid %d)\n", hipGetErrorString(e), grid);
}
```

```cpp
#include <hip/hip_runtime.h>
#include <hip/hip_cooperative_groups.h>
#include <cstdio>
#include <cstdint>
namespace cg = cooperative_groups;

#define LAS __attribute__((address_space(3)))
typedef unsigned short bf16_t;
typedef short bf16x8 __attribute__((ext_vector_type(8)));
typedef float f32x4 __attribute__((ext_vector_type(4)));
typedef unsigned u32x4 __attribute__((ext_vector_type(4)));
typedef unsigned u32x2 __attribute__((ext_vector_type(2)));

constexpr int DM = 1024, TP = 16384, TS = 128, MV = 16512, MPAD = 16640, NINC = 2048, DFF = 2816, NUP = 5632, PLE = 256;
constexpr float EPS = 1e-6f;
constexpr size_t O_Y = 0, O_PP = 16908288, O_CP = 16969728, O_FP = 16977920, O_PS = 17068032, O_CS = 18051072, O_FS = 18182144;
constexpr size_t MiB = 1u << 20;
constexpr size_t WS_WIN = 0, WS_WOUT = 4 * MiB, WS_WUP = 6 * MiB, WS_WDOWN = 17 * MiB, WS_WG = 22 * MiB + MiB / 2, WS_WP = 24 * MiB + MiB / 2, WS_WPOOL = 25 * MiB,
                 WS_RSTD1 = 25 * MiB + MiB / 4, WS_SSQ2 = 25 * MiB + MiB / 2, WS_SSQ3 = 27 * MiB, WS_UPB = 28 * MiB + MiB / 2, WS_RB = 35 * MiB,
                 WS_XB = 68 * MiB, WS_PROJ = 101 * MiB, WS_MIX = 166 * MiB, WS_ACT = 68 * MiB, WS_PP = 166 * MiB, WS_PB = 199 * MiB, WS_BAR = 208 * MiB, WS_SSQ2S = 208 * MiB + MiB / 4, WS_SSQ3S = 208 * MiB + MiB / 2, WS_END = 209 * MiB;

struct Params {
    const float *x_prompt, *x_sample, *state_pool, *state_conv, *state_ffn, *p_prompt, *p_sample;
    const float *g_mix, *w_in, *w_pool, *pool_scale, *conv_w, *conv_b, *w_out, *g_ffn, *w_up, *ffn_conv_w, *ffn_conv_b, *w_down, *g_ple, *w_ple_gate, *w_ple_proj, *g_final;
    float* out; unsigned char* ws;
    int ph_lo, ph_hi;
};

__device__ __forceinline__ unsigned cvt_pk_bf16(float lo, float hi) { unsigned r; asm volatile("v_cvt_pk_bf16_f32 %0, %1, %2" : "=v"(r) : "v"(lo), "v"(hi)); return r; }
__device__ __forceinline__ float bf_lo(unsigned w) { return __uint_as_float(w << 16); }
__device__ __forceinline__ float bf_hi(unsigned w) { return __uint_as_float(w & 0xffff0000u); }
__device__ __forceinline__ float sigmoidf_(float x) { return __builtin_amdgcn_rcpf(1.0f + __expf(-x)); }

namespace pg8 {
constexpr int BM = 256, BK = 64, HALF = 128, HTB = HALF * BK * 2, STAGE_BYTES = 8 * HTB, NXCD = 8, WGM = 8;
__host__ __device__ __forceinline__ int lds_byte(int r, int c) { const int st = (r >> 4) * 2 + (c >> 5), rr = r & 15, cc = c & 31, ob = rr * 64 + cc * 2; return st * 1024 + (ob ^ (((ob >> 9) & 1) << 5)); }
__host__ __device__ __forceinline__ void stage_rc(int b, int& R, int& C) { const int st = b / 1024, sb = b % 1024, swz = sb ^ (((sb >> 9) & 1) << 5); R = (st >> 1) * 16 + swz / 64; C = (st & 1) * 32 + (swz % 64) / 2; }
__host__ __device__ __forceinline__ int perm32(int rho) { const int n = rho >> 4, i = rho & 15; return 8 * (i >> 2) + 4 * n + (i & 3); }
struct Unit { int pm, pn; };
struct Gemm { const bf16_t* A; const bf16_t* Bt; int M, N, K; };
struct StaticOrder {
    int nM, nN, nwg, G, c;
    int pm_off;
    __device__ void init(int M, int N, int G_, int c_, int pm_off_ = 0) { nM = M / BM; nN = N / BM; nwg = nM * nN; G = G_; c = c_; pm_off = pm_off_; }
    __device__ bool next(int i, Unit& u) const {
        const long L = (long)i * G + c; if (L >= nwg) return false;
        int wgid = (int)L; { const int q = nwg / NXCD, r = nwg % NXCD, xcd = wgid % NXCD, off = wgid / NXCD; wgid = (xcd < r ? xcd * (q + 1) : r * (q + 1) + (xcd - r) * q) + off; }
        const int nig = WGM * nN, gid = wgid / nig, fm = gid * WGM, gsz = (nM - fm) < WGM ? (nM - fm) : WGM;
        u.pm = pm_off + fm + ((wgid % nig) % gsz); u.pn = (wgid % nig) / gsz; return true;
    }
};

template <class Epi>
__device__ __forceinline__ void gemm_phase(LAS unsigned char* lds, const Gemm g, const StaticOrder& S, const Epi& E) {
    int tid_ = threadIdx.x; asm volatile("" : "+v"(tid_));
    const int tid = tid_, wid = __builtin_amdgcn_readfirstlane(tid >> 6), lane = tid & 63, wr = wid >> 2, wc = wid & 3, fr = lane & 15, fq = lane >> 4;
    const int K = g.K, nt = K / BK;
    unsigned voffA[2], voffB[2];
#pragma unroll
    for (int i = 0; i < 2; ++i) { int R, C; stage_rc(tid * 16 + i * 8192, R, C); const int Rb = Epi::PERM ? ((R & ~31) + perm32(R & 31)) : R;
        voffA[i] = (unsigned)(R * K + C) * 2u; voffB[i] = (unsigned)(Rb * K + C) * 2u; }
    const size_t kstep = (size_t)(BK * 2);
    const size_t hstep = (size_t)HALF * K * 2;
    const size_t tstep = 2 * hstep;
    const unsigned ldsw = (unsigned)wid * 1024u;
    const int aoff = lds_byte(wr * 64 + fr, fq * 8), boff = lds_byte(wc * 32 + fr, fq * 8);
#define PG8_SA(b, h) (((b) * 2 + (h)) * HTB)
#define PG8_SB(b, h) ((4 + (b) * 2 + (h)) * HTB)
#define PG8_STAGE(bufoff, gbase, voff) do { _Pragma("unroll") for (int _i = 0; _i < 2; ++_i) \
        __builtin_amdgcn_global_load_lds((const unsigned*)((const char*)(gbase) + (voff)[_i]), (LAS unsigned*)(lds + (bufoff) + ldsw + _i * 8192), 16, 0, 0); } while (0)
#define PG8_LDA(dst, b, h) do { _Pragma("unroll") for (int m = 0; m < 4; ++m) _Pragma("unroll") for (int k = 0; k < 2; ++k) dst[m][k] = *(const LAS bf16x8*)(lds + PG8_SA(b, h) + aoff + m * 2048 + k * 1024); } while (0)
#define PG8_LDB(dst, b, h) do { _Pragma("unroll") for (int n = 0; n < 2; ++n) _Pragma("unroll") for (int k = 0; k < 2; ++k) dst[n][k] = *(const LAS bf16x8*)(lds + PG8_SB(b, h) + boff + n * 2048 + k * 1024); } while (0)
#define PG8_MMA(ai, bj, At, Bt) do { __builtin_amdgcn_s_setprio(1); _Pragma("unroll") for (int m = 0; m < 4; ++m) _Pragma("unroll") for (int n = 0; n < 2; ++n) _Pragma("unroll") for (int k = 0; k < 2; ++k) \
        acc[ai][bj][m][n] = __builtin_amdgcn_mfma_f32_16x16x32_bf16(Bt[n][k], At[m][k], acc[ai][bj][m][n], 0, 0, 0); __builtin_amdgcn_s_setprio(0); } while (0)
#define PG8_WAIT_V(n) asm volatile("s_waitcnt vmcnt(" #n ")" ::: "memory")
#define PG8_WAIT_L(n) asm volatile("s_waitcnt lgkmcnt(" #n ")" ::: "memory")
#define PG8_BAR __builtin_amdgcn_s_barrier()
#define PG8_SCHED __builtin_amdgcn_sched_barrier(0)
    Unit cur, nxt; int ui = 0;
    if (!S.next(0, cur)) return;
    f32x4 acc[2][2][4][2];
#pragma unroll
    for (int a = 0; a < 2; ++a)
#pragma unroll
        for (int b = 0; b < 2; ++b)
#pragma unroll
            for (int m = 0; m < 4; ++m)
#pragma unroll
                for (int n = 0; n < 2; ++n) acc[a][b][m][n] = (f32x4){0.f, 0.f, 0.f, 0.f};
    bf16x8 At[4][2], B0[2][2], B1[2][2];
    const char* cA = (const char*)g.A + (size_t)cur.pm * tstep; const char* cB = (const char*)g.Bt + (size_t)cur.pn * tstep;
    PG8_STAGE(PG8_SB(0, 0), cB, voffB); PG8_STAGE(PG8_SB(0, 1), cB + hstep, voffB); PG8_STAGE(PG8_SA(0, 0), cA, voffA); PG8_STAGE(PG8_SA(0, 1), cA + hstep, voffA);
    if (wr == 1) PG8_BAR;
    PG8_WAIT_V(2); PG8_BAR;
    PG8_STAGE(PG8_SB(1, 0), cB + kstep, voffB); PG8_STAGE(PG8_SA(1, 0), cA + kstep, voffA); PG8_STAGE(PG8_SB(1, 1), cB + hstep + kstep, voffB);
    PG8_WAIT_V(6); PG8_BAR;
    for (;;) {
        const bool has_next = S.next(ui + 1, nxt);
        const char* nA = has_next ? (const char*)g.A + (size_t)nxt.pm * tstep : cA; const char* nB = has_next ? (const char*)g.Bt + (size_t)nxt.pn * tstep : cB;
        for (int t = 0; t < nt; t += 2) {
            const bool last = (t == nt - 2);
            const char* a1 = cA + (size_t)(t + 1) * kstep;
            const char* a2 = last ? nA : cA + (size_t)(t + 2) * kstep; const char* b2 = last ? nB : cB + (size_t)(t + 2) * kstep;
            const char* a3 = a2 + kstep; const char* b3 = b2 + kstep;
            PG8_LDB(B0, 0, 0); PG8_LDB(B1, 0, 1); PG8_SCHED; PG8_LDA(At, 0, 0); PG8_STAGE(PG8_SA(1, 1), a1 + hstep, voffA);
            PG8_WAIT_V(8); PG8_WAIT_L(0); PG8_BAR; PG8_MMA(0, 0, At, B0); PG8_MMA(0, 1, At, B1); PG8_BAR; PG8_SCHED;
            PG8_LDA(At, 0, 1); PG8_STAGE(PG8_SB(0, 0), b2, voffB); PG8_STAGE(PG8_SB(0, 1), b2 + hstep, voffB); PG8_STAGE(PG8_SA(0, 0), a2, voffA);
            PG8_WAIT_V(8); PG8_WAIT_L(0); PG8_BAR; PG8_MMA(1, 0, At, B0); PG8_MMA(1, 1, At, B1); PG8_BAR; PG8_SCHED;
            PG8_LDB(B0, 1, 0); PG8_LDB(B1, 1, 1); PG8_SCHED; PG8_LDA(At, 1, 0); PG8_STAGE(PG8_SA(0, 1), a2 + hstep, voffA);
            PG8_WAIT_V(8); PG8_WAIT_L(0); PG8_BAR; PG8_MMA(0, 0, At, B0); PG8_MMA(0, 1, At, B1); PG8_BAR; PG8_SCHED;
            PG8_LDA(At, 1, 1); PG8_STAGE(PG8_SB(1, 0), b3, voffB); PG8_STAGE(PG8_SB(1, 1), b3 + hstep, voffB); PG8_STAGE(PG8_SA(1, 0), a3, voffA);
            PG8_WAIT_V(8); PG8_WAIT_L(0); PG8_BAR; PG8_MMA(1, 0, At, B0); PG8_MMA(1, 1, At, B1); PG8_BAR; PG8_SCHED;
        }
        if (wr == 0) PG8_BAR;
        E(acc, cur, wr, wc, fr, fq, lds + STAGE_BYTES, lane);
        if (!has_next) break;
#pragma unroll
        for (int a = 0; a < 2; ++a)
#pragma unroll
            for (int b = 0; b < 2; ++b)
#pragma unroll
                for (int m = 0; m < 4; ++m)
#pragma unroll
                    for (int n = 0; n < 2; ++n) acc[a][b][m][n] = (f32x4){0.f, 0.f, 0.f, 0.f};
        cur = nxt; cA = nA; cB = nB; ++ui;
        if (wr == 1) PG8_BAR;
    }
    PG8_WAIT_V(0);
    PG8_BAR;
#undef PG8_SA
#undef PG8_SB
#undef PG8_STAGE
#undef PG8_LDA
#undef PG8_LDB
#undef PG8_MMA
#undef PG8_WAIT_V
#undef PG8_WAIT_L
#undef PG8_BAR
#undef PG8_SCHED
}
}
using pg8::Unit;

struct EpiScaleBf16 {
    static constexpr bool PERM = true;
    bf16_t* O; int ldc; const float* rstd;
    __device__ __forceinline__ void operator()(f32x4 (&acc)[2][2][4][2], const Unit& u, int wr, int wc, int fr, int fq, LAS unsigned char*, int) const {
        const int row0 = u.pm * 256 + wr * 64 + fr, col0 = u.pn * 256 + wc * 32 + 8 * fq;
#pragma unroll
        for (int ai = 0; ai < 2; ++ai)
#pragma unroll
            for (int m = 0; m < 4; ++m) { const int row = row0 + ai * 128 + m * 16; const float rs = rstd ? rstd[row] : 1.0f; bf16_t* rowp = O + (size_t)row * ldc + col0;
#pragma unroll
                for (int bj = 0; bj < 2; ++bj) { const f32x4 v0 = acc[ai][bj][m][0] * rs, v1 = acc[ai][bj][m][1] * rs;
                    u32x4 w; w.x = cvt_pk_bf16(v0[0], v0[1]); w.y = cvt_pk_bf16(v0[2], v0[3]); w.z = cvt_pk_bf16(v1[0], v1[1]); w.w = cvt_pk_bf16(v1[2], v1[3]);
                    *(u32x4*)(rowp + bj * 128) = w; } }
    }
};
struct EpiRes {
    static constexpr bool PERM = false;
    const float* base_p; const float* base_s;
    float* out; bf16_t* rb; float* ssq;
    __device__ __forceinline__ void operator()(f32x4 (&acc)[2][2][4][2], const Unit& u, int wr, int wc, int fr, int fq, LAS unsigned char*, int) const {
        const int row0 = u.pm * 256 + wr * 64 + fr, col0 = u.pn * 256 + wc * 32 + 4 * fq;
#pragma unroll
        for (int ai = 0; ai < 2; ++ai)
#pragma unroll
            for (int m = 0; m < 4; ++m) { const int row = row0 + ai * 128 + m * 16; const bool valid = row < MV;
                const float* bp = (row < TP) ? base_p + (size_t)row * DM : base_s + (size_t)(row - TP) * DM;
                float ss = 0.f;
#pragma unroll
                for (int bj = 0; bj < 2; ++bj)
#pragma unroll
                    for (int n = 0; n < 2; ++n) { const int c = col0 + bj * 128 + n * 16;
                        f32x4 b = (f32x4){0.f, 0.f, 0.f, 0.f}; if (valid) b = *(const f32x4*)(bp + c);
                        const f32x4 o = b + acc[ai][bj][m][n]; ss += (o[0] * o[0] + o[1] * o[1]) + (o[2] * o[2] + o[3] * o[3]);
                        if (valid) *(f32x4*)(out + (size_t)row * DM + c) = o;
                        u32x2 w; w.x = cvt_pk_bf16(o[0], o[1]); w.y = cvt_pk_bf16(o[2], o[3]); *(u32x2*)(rb + (size_t)row * DM + c) = w; }
                ss += __shfl_xor(ss, 16); ss += __shfl_xor(ss, 32);
                if (fq == 0) ssq[(size_t)row * 16 + u.pn * 4 + wc] = ss; }
    }
};
__device__ __forceinline__ float rstd_from_ssq(const float* ssq, int row) {
    const f32x4* s = (const f32x4*)(ssq + (size_t)row * 16); const f32x4 a = s[0], b = s[1], c = s[2], d = s[3];
    const float t = ((a[0] + a[1]) + (a[2] + a[3])) + ((b[0] + b[1]) + (b[2] + b[3])) + ((c[0] + c[1]) + (c[2] + c[3])) + ((d[0] + d[1]) + (d[2] + d[3]));
    return rsqrtf(t * (1.0f / DM) + EPS);
}
__device__ __forceinline__ float rstd_from_ssq4(const float* ssq, int row, int fq) {
    const f32x4 a = ((const f32x4*)(ssq + (size_t)row * 16))[fq];
    float t = (a[0] + a[1]) + (a[2] + a[3]); t += __shfl_xor(t, 16); t += __shfl_xor(t, 32);
    return rsqrtf(t * (1.0f / DM) + EPS);
}
struct EpiGate {
    static constexpr bool PERM = false;
    float* out; const bf16_t* pp; const float* ssq;
    __device__ __forceinline__ void operator()(f32x4 (&acc)[2][2][4][2], const Unit& u, int wr, int wc, int fr, int fq, LAS unsigned char*, int) const {
        const int row0 = u.pm * 256 + wr * 64 + fr, col0 = u.pn * 256 + wc * 32 + 4 * fq;
#pragma unroll
        for (int ai = 0; ai < 2; ++ai)
#pragma unroll
            for (int m = 0; m < 4; ++m) { const int row = row0 + ai * 128 + m * 16; const float rs = rstd_from_ssq4(ssq, row, fq); if (row >= MV) continue;
#pragma unroll
                for (int bj = 0; bj < 2; ++bj)
#pragma unroll
                    for (int n = 0; n < 2; ++n) { const int c = col0 + bj * 128 + n * 16; const size_t off = (size_t)row * DM + c;
                        const f32x4 r2 = *(const f32x4*)(out + off); const u32x2 pw = *(const u32x2*)(pp + off); const f32x4 a = acc[ai][bj][m][n] * rs;
                        f32x4 o; o[0] = r2[0] + sigmoidf_(a[0]) * bf_lo(pw.x); o[1] = r2[1] + sigmoidf_(a[1]) * bf_hi(pw.x); o[2] = r2[2] + sigmoidf_(a[2]) * bf_lo(pw.y); o[3] = r2[3] + sigmoidf_(a[3]) * bf_hi(pw.y);
                        *(f32x4*)(out + off) = o; } }
    }
};
template <bool SAMPLE> struct EpiUp {
    static constexpr bool PERM = false;
    const float* ssq; const float* cw; const float* cb; const float* st_ffn; float* new_ffn_s; bf16_t* act; float* upb;
    __device__ __forceinline__ void operator()(f32x4 (&acc)[2][2][4][2], const Unit& u, int wr, int wc, int fr, int fq, LAS unsigned char* ex, int lane) const {
        const int rowb = u.pm * 256 + wr * 64 + fr;
#pragma unroll
        for (int ai = 0; ai < 2; ++ai)
#pragma unroll
            for (int m = 0; m < 4; ++m) { float rs;
                if constexpr (SAMPLE) { rs = 0.f; if (ai == 0) { const int r = wr * 64 + m * 16 + fr; const f32x4* p = (const f32x4*)(ssq + (size_t)r * 64) + 4 * fq; float t = 0.f;
#pragma unroll
                        for (int i = 0; i < 4; ++i) { const f32x4 a = p[i]; t += (a[0] + a[1]) + (a[2] + a[3]); }
                        t += __shfl_xor(t, 16); t += __shfl_xor(t, 32); rs = rsqrtf(t * (1.0f / DM) + EPS); } }
                else rs = rstd_from_ssq4(ssq, rowb + ai * 128 + m * 16, fq);
#pragma unroll
                for (int bj = 0; bj < 2; ++bj)
#pragma unroll
                    for (int n = 0; n < 2; ++n) acc[ai][bj][m][n] = acc[ai][bj][m][n] * rs; }
        constexpr bool sample = SAMPLE;
        const int chl = u.pn * 128 + wc * 32 + 4 * fq;
        const int e16 = (wc * 4 + fq) * 16;
        if constexpr (!sample) {
            if (fr >= 14) {
#pragma unroll
                for (int ai = 0; ai < 2; ++ai) { const int slab = 2 * ai + wr;
#pragma unroll
                    for (int bj = 0; bj < 2; ++bj)
#pragma unroll
                        for (int n = 0; n < 2; ++n) *(LAS f32x4*)(ex + ((((slab * 2 + (fr - 14)) * 2 + bj) * 2 + n) * 256 + e16)) = acc[ai][bj][3][n]; }
                if (wr == 1) {
#pragma unroll
                    for (int bj = 0; bj < 2; ++bj)
#pragma unroll
                        for (int n = 0; n < 2; ++n) *(f32x4*)(upb + (size_t)(u.pm * 4 + 2 + (fr - 14)) * NUP + bj * DFF + chl + 16 * n) = acc[1][bj][3][n]; }
            }
            if (wr == 0 && fr < 2) {
#pragma unroll
                for (int bj = 0; bj < 2; ++bj)
#pragma unroll
                    for (int n = 0; n < 2; ++n) *(f32x4*)(upb + (size_t)(u.pm * 4 + fr) * NUP + bj * DFF + chl + 16 * n) = acc[0][bj][0][n]; }
        }
        asm volatile("s_waitcnt lgkmcnt(0)" ::: "memory"); __builtin_amdgcn_s_barrier(); asm volatile("" ::: "memory");
        const int src1 = (lane & 48) | ((fr + 15) & 15), src2 = (lane & 48) | ((fr + 14) & 15);
#define EPIUP_LOADW() f32x4 w0[2], w1[2], w2[2], bb[2]; _Pragma("unroll") for (int bj = 0; bj < 2; ++bj) { const int col = bj * DFF + chl + 16 * n; \
                w0[bj] = *(const f32x4*)(cw + col); w1[bj] = *(const f32x4*)(cw + NUP + col); w2[bj] = *(const f32x4*)(cw + 2 * NUP + col); bb[bj] = *(const f32x4*)(cb + col); }
        if constexpr (!sample) {
#pragma unroll
            for (int n = 0; n < 2; ++n) { EPIUP_LOADW();
#pragma unroll
                for (int ai = 0; ai < 2; ++ai) { const int slab = 2 * ai + wr;
                    f32x4 pv[2];
#pragma unroll
                    for (int bj = 0; bj < 2; ++bj) { pv[bj] = (f32x4){0.f, 0.f, 0.f, 0.f};
                        if (slab > 0 && fr >= 14) pv[bj] = *(const LAS f32x4*)(ex + (((((slab - 1) * 2 + (fr - 14)) * 2 + bj) * 2 + n) * 256 + e16)); }
#pragma unroll
                    for (int m = 0; m < 4; ++m) { f32x4 cv[2];
#pragma unroll
                        for (int bj = 0; bj < 2; ++bj) { const f32x4 prev = (m == 0) ? pv[bj] : acc[ai][bj][m == 0 ? 0 : m - 1][n]; const f32x4 cur = acc[ai][bj][m][n];
#pragma unroll
                            for (int i = 0; i < 4; ++i) { const float sa = (fr >= 14) ? prev[i] : cur[i], sb = (fr == 15) ? prev[i] : cur[i];
                                const float p2 = __shfl(sa, src2), p1 = __shfl(sb, src1);
                                cv[bj][i] = w0[bj][i] * p2 + w1[bj][i] * p1 + w2[bj][i] * cur[i] + bb[bj][i]; } }
                        float o[4];
#pragma unroll
                        for (int i = 0; i < 4; ++i) o[i] = cv[0][i] * sigmoidf_(cv[0][i]) * cv[1][i];
                        u32x2 w; w.x = cvt_pk_bf16(o[0], o[1]); w.y = cvt_pk_bf16(o[2], o[3]);
                        *(u32x2*)(act + (size_t)(rowb + ai * 128 + m * 16) * DFF + chl + 16 * n) = w; __builtin_amdgcn_sched_barrier(0); } }
            }
        } else {
#pragma unroll
            for (int n = 0; n < 2; ++n) { EPIUP_LOADW();
#pragma unroll
                for (int m = 0; m < 4; ++m) { const int rn = wr * 64 + m * 16 + fr; f32x4 cv[2];
#pragma unroll
                    for (int bj = 0; bj < 2; ++bj) { const int col = bj * DFF + chl + 16 * n;
                        const f32x4 p2 = *(const f32x4*)(st_ffn + (size_t)(rn * 2) * NUP + col), p1 = *(const f32x4*)(st_ffn + (size_t)(rn * 2 + 1) * NUP + col), cur = acc[0][bj][m][n];
                        cv[bj] = w0[bj] * p2 + w1[bj] * p1 + w2[bj] * cur + bb[bj];
                        *(f32x4*)(new_ffn_s + (size_t)(rn * 2) * NUP + col) = p1; *(f32x4*)(new_ffn_s + (size_t)(rn * 2 + 1) * NUP + col) = cur; }
                    float o[4];
#pragma unroll
                    for (int i = 0; i < 4; ++i) o[i] = cv[0][i] * sigmoidf_(cv[0][i]) * cv[1][i];
                    u32x2 w; w.x = cvt_pk_bf16(o[0], o[1]); w.y = cvt_pk_bf16(o[2], o[3]);
                    *(u32x2*)(act + (size_t)(TP + rn) * DFF + chl + 16 * n) = w; __builtin_amdgcn_sched_barrier(0); }
            }
        }
#undef EPIUP_LOADW
    }
};


#define XB_TMO      128
#define XB_XCNT(j)  (256  + 64 * (j))
#define XB_XSUB(j)  (1280 + 64 * (j))
#define XB_XGEN(j)  (2304 + 64 * (j))
#define XB_TOP      3328
#define XB_TOPGEN   3392
#define XCD_BAR_WORDS 3456
#define XB_SPIN_CAP (1u << 18)
__device__ __forceinline__ unsigned xb_ld(unsigned* p)              { return __hip_atomic_load(p, __ATOMIC_RELAXED, __HIP_MEMORY_SCOPE_AGENT); }
__device__ __forceinline__ unsigned xb_add(unsigned* p, unsigned v) { return __hip_atomic_fetch_add(p, v, __ATOMIC_RELAXED, __HIP_MEMORY_SCOPE_AGENT); }
__device__ __forceinline__ unsigned xb_xcc_id() { return (unsigned)__builtin_amdgcn_s_getreg((3 << 11) | 20) & 0xFu; }
#define XB_SPIN(cond, bar) do { unsigned _sp = 0; while (cond) { __builtin_amdgcn_s_sleep(1); \
    if ((++_sp & 255u) == 0u) { if (xb_ld(&(bar)[XB_TMO])) break; if (_sp > XB_SPIN_CAP) { atomicAdd(&(bar)[XB_TMO], 1u); break; } } } } while (0)
struct XcdBarrier { unsigned* bar; unsigned x; volatile LAS unsigned* st; };
__device__ __forceinline__ XcdBarrier xcd_barrier_post(unsigned* bar, volatile LAS unsigned* st) {
    XcdBarrier b; b.bar = bar; b.x = xb_xcc_id(); b.st = st;
    if (threadIdx.x == 0) (void)xb_add(&bar[XB_XCNT(b.x)], 1u);
    return b;
}
__device__ __forceinline__ void xcd_barrier_complete(unsigned* bar, unsigned x, unsigned& nloc, unsigned& nx) {
    const unsigned G = gridDim.x * gridDim.y * gridDim.z;
    unsigned sum, cnt, mine, sp = 0u;
    for (;;) {
        sum = 0u; cnt = 0u; mine = 0u;
#pragma unroll
        for (unsigned j = 0; j < 16; ++j) { const unsigned c = xb_ld(&bar[XB_XCNT(j)]); sum += c; cnt += (c > 0u) ? 1u : 0u; mine = (j == x) ? c : mine; }
        if (sum == G) break;
        __builtin_amdgcn_s_sleep(1);
        if ((++sp & 255u) == 0u) { if (xb_ld(&bar[XB_TMO])) break; if (sp > XB_SPIN_CAP) { atomicAdd(&bar[XB_TMO], 1u); break; } }
    }
    nloc = mine > 0u ? mine : 1u; nx = cnt > 0u ? cnt : 1u;
}
__device__ __forceinline__ void xcd_barrier(const XcdBarrier& b) {
    asm volatile("s_waitcnt vmcnt(0)" ::: "memory");
    __syncthreads();
    if (threadIdx.x == 0) {
        unsigned* bar = b.bar;
        __builtin_amdgcn_s_waitcnt(0);
        unsigned nloc = b.st[0], nx = b.st[1];
        if (nloc == 0u) { xcd_barrier_complete(bar, b.x, nloc, nx); b.st[0] = nloc; b.st[1] = nx; }
        const unsigned old = xb_add(&bar[XB_XSUB(b.x)], 1u);
        const unsigned gen = old / nloc;
        if (old + 1u == (gen + 1u) * nloc) {
            __builtin_amdgcn_fence(__ATOMIC_RELEASE, "agent");
            asm volatile("s_waitcnt vmcnt(0)" ::: "memory");
            const unsigned og = xb_add(&bar[XB_TOP], 1u);
            const unsigned tg = og / nx;
            if (og + 1u == (tg + 1u) * nx) xb_add(&bar[XB_TOPGEN], 1u);
            else XB_SPIN(xb_ld(&bar[XB_TOPGEN]) == tg, bar);
            __builtin_amdgcn_fence(__ATOMIC_ACQUIRE, "agent");
            xb_add(&bar[XB_XGEN(b.x)], 1u);
            asm volatile("s_waitcnt vmcnt(0)" ::: "memory");
        } else {
            XB_SPIN(xb_ld(&bar[XB_XGEN(b.x)]) == gen, bar);
            __builtin_amdgcn_fence(__ATOMIC_ACQUIRE, "agent");
            asm volatile("s_waitcnt vmcnt(0)" ::: "memory");
        }
    }
    __syncthreads();
}

__device__ __forceinline__ f32x4 sgemm_piece(LAS unsigned char* lds, const bf16_t* A, const bf16_t* Bt, int K, int c0) {
    int tid_ = threadIdx.x; asm volatile("" : "+v"(tid_));
    const int tid = tid_, lane = tid & 63, wave = tid >> 6, fr = lane & 15, fq = lane >> 4;
    const int ksl = K / 8, k0 = wave * ksl;
    f32x4 acc[8];
#pragma unroll
    for (int rt = 0; rt < 8; ++rt) acc[rt] = (f32x4){0.f, 0.f, 0.f, 0.f};
    const bf16_t* bp = Bt + (size_t)(c0 + fr) * K + k0 + 8 * fq;
    const bf16_t* ap = A + (size_t)fr * K + k0 + 8 * fq;
    for (int ks = 0; ks < ksl; ks += 32) {
        const bf16x8 bfr = *(const bf16x8*)(bp + ks);
        bf16x8 afr[8];
#pragma unroll
        for (int rt = 0; rt < 8; ++rt) afr[rt] = *(const bf16x8*)(ap + (size_t)(16 * rt) * K + ks);
#pragma unroll
        for (int rt = 0; rt < 8; ++rt) acc[rt] = __builtin_amdgcn_mfma_f32_16x16x32_bf16(bfr, afr[rt], acc[rt], 0, 0, 0);
    }
    LAS float* red = (LAS float*)lds;
#pragma unroll
    for (int rt = 0; rt < 8; ++rt) *(LAS f32x4*)(red + (size_t)((wave * 128 + 16 * rt + fr) * 16 + 4 * fq)) = acc[rt];
    __syncthreads();
    f32x4 s = (f32x4){0.f, 0.f, 0.f, 0.f};
#pragma unroll
    for (int w = 0; w < 8; ++w) s += *(const LAS f32x4*)(red + (size_t)((w * 128 + (tid >> 2)) * 16 + 4 * (tid & 3)));
    __syncthreads();
    return s;
}
__device__ __forceinline__ float rstd_s64(const float* ssq, int r) {
    const f32x4* p = (const f32x4*)(ssq + (size_t)r * 64); float t = 0.f;
#pragma unroll
    for (int i = 0; i < 16; ++i) { const f32x4 a = p[i]; t += (a[0] + a[1]) + (a[2] + a[3]); }
    return rsqrtf(t * (1.0f / DM) + EPS);
}

__device__ __forceinline__ float wave_sum(float v) {
#pragma unroll
    for (int o = 1; o < 64; o <<= 1) v += __shfl_xor(v, o);
    return v;
}
__device__ __forceinline__ void transpose_item(const float* W, int K, int Nsrc, int k0, int oc0, const float* gk, bf16_t* WT, int orow0, LAS float* scr, int lane) {
#pragma unroll 8
    for (int i = 0; i < 32; ++i) { const int kk = 2 * i + (lane >> 5); float v = W[(size_t)(k0 + kk) * Nsrc + oc0 + (lane & 31)]; if (gk) v *= gk[k0 + kk]; scr[kk * 33 + (lane & 31)] = v; }
    asm volatile("s_waitcnt lgkmcnt(0)" ::: "memory");
    const int c = lane & 7;
#pragma unroll
    for (int j = 0; j < 4; ++j) { const int n = (lane >> 3) + 8 * j; const LAS float* s = scr + (8 * c) * 33 + n;
        u32x4 o; o.x = cvt_pk_bf16(s[0 * 33], s[1 * 33]); o.y = cvt_pk_bf16(s[2 * 33], s[3 * 33]); o.z = cvt_pk_bf16(s[4 * 33], s[5 * 33]); o.w = cvt_pk_bf16(s[6 * 33], s[7 * 33]);
        *(u32x4*)(WT + (size_t)(orow0 + n) * K + k0 + 8 * c) = o; }
    asm volatile("s_waitcnt lgkmcnt(0)" ::: "memory");
}
__device__ __forceinline__ void p0_prep(const Params& P, LAS unsigned char* lds) {
    const int tid = threadIdx.x, lane = tid & 63, wave = tid >> 6;
    const int gw = blockIdx.x * 8 + wave, NGW = gridDim.x * 8;
    unsigned char* ws = P.ws;
    LAS float* scr = (LAS float*)(lds + wave * 8704);
    constexpr int I_IN = 16 * 64, I_OUT = 16 * 32, I_UP = 16 * 176, I_DN = 44 * 32, I_G = 16 * 32, I_P = 4 * 32, I_PL = 4 * 2 * 4;
    constexpr int NIT = I_IN + I_OUT + I_UP + I_DN + I_G + I_P + I_PL;
    for (int it = gw; it < NIT; it += NGW) {
        int r = it;
        if (r < I_IN) { const int kb = r / 64, nb = r % 64; transpose_item(P.w_in, DM, NINC, 64 * kb, 32 * nb, P.g_mix, (bf16_t*)(ws + WS_WIN), 32 * nb, scr, lane); continue; } r -= I_IN;
        if (r < I_OUT) { const int kb = r / 32, nb = r % 32; transpose_item(P.w_out, DM, DM, 64 * kb, 32 * nb, nullptr, (bf16_t*)(ws + WS_WOUT), 32 * nb, scr, lane); continue; } r -= I_OUT;
        if (r < I_UP) { const int kb = r / 176, nb = r % 176; const int c = 32 * nb; const int oc = ((c & 255) >= 128 ? DFF : 0) + 128 * (c >> 8) + (c & 127);
            transpose_item(P.w_up, DM, NUP, 64 * kb, oc, P.g_ffn, (bf16_t*)(ws + WS_WUP), c, scr, lane); continue; } r -= I_UP;
        if (r < I_DN) { const int kb = r / 32, nb = r % 32; transpose_item(P.w_down, DFF, DM, 64 * kb, 32 * nb, nullptr, (bf16_t*)(ws + WS_WDOWN), 32 * nb, scr, lane); continue; } r -= I_DN;
        if (r < I_G) { const int kb = r / 32, nb = r % 32; transpose_item(P.w_ple_gate, DM, DM, 64 * kb, 32 * nb, P.g_ple, (bf16_t*)(ws + WS_WG), 32 * nb, scr, lane); continue; } r -= I_G;
        if (r < I_P) { const int kb = r / 32, nb = r % 32; transpose_item(P.w_ple_proj, PLE, DM, 64 * kb, 32 * nb, nullptr, (bf16_t*)(ws + WS_WP), 32 * nb, scr, lane); continue; } r -= I_P;
        { const int gI = r / 8, q = r % 8, kb = q / 4, nb = q % 4; transpose_item(P.w_pool + (size_t)gI * 128 * 128, 128, 128, 64 * kb, 32 * nb, nullptr, (bf16_t*)(ws + WS_WPOOL) + (size_t)gI * 128 * 128, 32 * nb, scr, lane); }
    }
    bf16_t* XB = (bf16_t*)(ws + WS_XB); float* RSTD1 = (float*)(ws + WS_RSTD1);
    for (int row = gw; row < MPAD; row += NGW) {
        unsigned long long* o8 = (unsigned long long*)(XB + (size_t)row * DM) + lane;
        if (row < MV) {
            const float* xr = (row < TP) ? P.x_prompt + (size_t)row * DM : P.x_sample + (size_t)(row - TP) * DM;
            const f32x4* x4 = (const f32x4*)xr + lane; f32x4 v[4]; float s = 0.f;
#pragma unroll
            for (int j = 0; j < 4; ++j) { v[j] = x4[64 * j]; s += (v[j][0] * v[j][0] + v[j][1] * v[j][1]) + (v[j][2] * v[j][2] + v[j][3] * v[j][3]); }
            s = wave_sum(s);
            if (lane == 0) RSTD1[row] = rsqrtf(s * (1.0f / DM) + EPS);
#pragma unroll
            for (int j = 0; j < 4; ++j) o8[64 * j] = (unsigned long long)cvt_pk_bf16(v[j][0], v[j][1]) | ((unsigned long long)cvt_pk_bf16(v[j][2], v[j][3]) << 32);
        } else {
#pragma unroll
            for (int j = 0; j < 4; ++j) o8[64 * j] = 0ull;
            if (lane == 0) RSTD1[row] = 0.f;
        }
    }
    bf16_t* PB = (bf16_t*)(ws + WS_PB);
    const int gt = blockIdx.x * 512 + tid, NGT = gridDim.x * 512;
    for (int i = gt; i < MPAD * 64; i += NGT) { const int row = i >> 6, c4 = (i & 63) * 4; u32x2 w; w.x = 0u; w.y = 0u;
        if (row < MV) { const float* pr = (row < TP) ? P.p_prompt + (size_t)row * PLE : P.p_sample + (size_t)(row - TP) * PLE; const f32x4 v = *(const f32x4*)(pr + c4); w.x = cvt_pk_bf16(v[0], v[1]); w.y = cvt_pk_bf16(v[2], v[3]); }
        *(u32x2*)(PB + (size_t)row * PLE + c4) = w; }
}

__device__ __forceinline__ void unpack8(const u32x4 w, float (&f)[8]) { f[0] = bf_lo(w.x); f[1] = bf_hi(w.x); f[2] = bf_lo(w.y); f[3] = bf_hi(w.y); f[4] = bf_lo(w.z); f[5] = bf_hi(w.z); f[6] = bf_lo(w.w); f[7] = bf_hi(w.w); }
__device__ __forceinline__ void p2_mix(const Params& P, LAS unsigned char* lds) {
    const int tid = threadIdx.x, lane = tid & 63, wave = tid >> 6, fr = lane & 15, fq = lane >> 4;
    unsigned char* ws = P.ws;
    const bf16_t* PROJ = (const bf16_t*)(ws + WS_PROJ); bf16_t* MIX = (bf16_t*)(ws + WS_MIX); const bf16_t* WPT = (const bf16_t*)(ws + WS_WPOOL);
    float* out = P.out;
    {
        const int gt = blockIdx.x * 512 + tid, NGT = gridDim.x * 512;
        for (int i = gt; i < MV * 64; i += NGT) { const int row = i >> 6, c8 = (i & 63) * 8;
            float w0[8], w1[8], w2[8], bb[8];
#pragma unroll
            for (int h = 0; h < 2; ++h) { const f32x4 a = *(const f32x4*)(P.conv_w + c8 + 4 * h), b = *(const f32x4*)(P.conv_w + 512 + c8 + 4 * h), c = *(const f32x4*)(P.conv_w + 1024 + c8 + 4 * h), d = *(const f32x4*)(P.conv_b + c8 + 4 * h);
#pragma unroll
                for (int e = 0; e < 4; ++e) { w0[4 * h + e] = a[e]; w1[4 * h + e] = b[e]; w2[4 * h + e] = c[e]; bb[4 * h + e] = d[e]; } }
            const bf16_t* pr = PROJ + (size_t)row * NINC;
            float bg[8], cg[8], hv[8], z0[8], z1[8], z2[8];
            unpack8(*(const u32x4*)(pr + 512 + c8), bg); unpack8(*(const u32x4*)(pr + 1024 + c8), cg); unpack8(*(const u32x4*)(pr + 1536 + c8), hv);
#pragma unroll
            for (int e = 0; e < 8; ++e) { z0[e] = cg[e] * hv[e]; z1[e] = 0.f; z2[e] = 0.f; }
            if (row < TP) { const int tl = row & 2047;
                if (tl >= 1) { unpack8(*(const u32x4*)(pr - NINC + 1024 + c8), cg); unpack8(*(const u32x4*)(pr - NINC + 1536 + c8), hv);
#pragma unroll
                    for (int e = 0; e < 8; ++e) z1[e] = cg[e] * hv[e]; }
                if (tl >= 2) { unpack8(*(const u32x4*)(pr - 2 * NINC + 1024 + c8), cg); unpack8(*(const u32x4*)(pr - 2 * NINC + 1536 + c8), hv);
#pragma unroll
                    for (int e = 0; e < 8; ++e) z2[e] = cg[e] * hv[e]; }
                if (tl >= 2046) { float* o = out + O_CP + (size_t)((row >> 11) * 2 + (tl - 2046)) * 512 + c8;
                    *(f32x4*)o = (f32x4){z0[0], z0[1], z0[2], z0[3]}; *(f32x4*)(o + 4) = (f32x4){z0[4], z0[5], z0[6], z0[7]}; }
            } else { const int n = row - TP; const float* sc = P.state_conv + (size_t)(n * 2) * 512 + c8;
                const f32x4 a0 = *(const f32x4*)sc, a1 = *(const f32x4*)(sc + 4), b0 = *(const f32x4*)(sc + 512), b1 = *(const f32x4*)(sc + 516);
#pragma unroll
                for (int e = 0; e < 4; ++e) { z2[e] = a0[e]; z2[4 + e] = a1[e]; z1[e] = b0[e]; z1[4 + e] = b1[e]; }
                float* o = out + O_CS + (size_t)(n * 2) * 512 + c8;
                *(f32x4*)o = b0; *(f32x4*)(o + 4) = b1; *(f32x4*)(o + 512) = (f32x4){z0[0], z0[1], z0[2], z0[3]}; *(f32x4*)(o + 516) = (f32x4){z0[4], z0[5], z0[6], z0[7]}; }
            float y[8];
#pragma unroll
            for (int e = 0; e < 8; ++e) y[e] = bg[e] * (w0[e] * z2[e] + w1[e] * z1[e] + w2[e] * z0[e] + bb[e]);
            u32x4 w; w.x = cvt_pk_bf16(y[0], y[1]); w.y = cvt_pk_bf16(y[2], y[3]); w.z = cvt_pk_bf16(y[4], y[5]); w.w = cvt_pk_bf16(y[6], y[7]);
            *(u32x4*)(MIX + (size_t)row * DM + 512 + c8) = w; }
    }
    LAS bf16_t* U = (LAS bf16_t*)lds;
    LAS bf16_t* Dm = (LAS bf16_t*)(lds + 36864);
    for (int item = blockIdx.x; item < 129 * 4; item += gridDim.x) {
        const int ti = item >> 2, g = item & 3, w = 2 << g, t0 = ti * 128;
        const int ch8 = tid & 15, rg = tid >> 4;
        if (ti < 128) {
            const bool has_halo = (t0 & 2047) != 0;
            for (int c = tid; c < 143 * 16; c += 512) { const int r = c >> 4, ch = c & 15; u32x4 v = (u32x4){0u, 0u, 0u, 0u};
                if (r >= 15 || has_halo) v = *(const u32x4*)(PROJ + (size_t)(t0 - 15 + r) * NINC + g * 128 + ch * 8);
                *(LAS u32x4*)(U + r * 128 + ch * 8) = v; }
            __syncthreads();
#pragma unroll 1
            for (int rr = 0; rr < 4; ++rr) { const int r = 4 * rg + rr, tl = (t0 + r) & 2047; const int cnt = (tl + 1 < w) ? tl + 1 : w;
                float s[8], cur[8], t8[8];
#pragma unroll
                for (int e = 0; e < 8; ++e) s[e] = 0.f;
                for (int i = 0; i < w; ++i) { unpack8(*(const LAS u32x4*)(U + (15 + r - i) * 128 + ch8 * 8), t8);
#pragma unroll
                    for (int e = 0; e < 8; ++e) s[e] += t8[e]; }
                unpack8(*(const LAS u32x4*)(U + (15 + r) * 128 + ch8 * 8), cur);
                const float inv = 1.0f / (float)cnt; float d[8];
#pragma unroll
                for (int e = 0; e < 8; ++e) d[e] = s[e] * inv - cur[e];
                u32x4 o; o.x = cvt_pk_bf16(d[0], d[1]); o.y = cvt_pk_bf16(d[2], d[3]); o.z = cvt_pk_bf16(d[4], d[5]); o.w = cvt_pk_bf16(d[6], d[7]);
                *(LAS u32x4*)(Dm + r * 136 + ch8 * 8) = o;
                if ((ti & 15) == 15 && r >= 113) { float* o2 = out + O_PP + (size_t)((ti >> 4) * 15 + (r - 113)) * 512 + g * 128 + ch8 * 8;
                    *(f32x4*)o2 = (f32x4){cur[0], cur[1], cur[2], cur[3]}; *(f32x4*)(o2 + 4) = (f32x4){cur[4], cur[5], cur[6], cur[7]}; } }
        } else {
#pragma unroll 1
            for (int rr = 0; rr < 4; ++rr) { const int n = 4 * rg + rr; float cur[8], s[8];
                unpack8(*(const u32x4*)(PROJ + (size_t)(TP + n) * NINC + g * 128 + ch8 * 8), cur);
#pragma unroll
                for (int e = 0; e < 8; ++e) s[e] = cur[e];
                const float* sp = P.state_pool + (size_t)n * 15 * 512 + g * 128 + ch8 * 8;
                for (int i = 1; i < w; ++i) { const f32x4 a = *(const f32x4*)(sp + (size_t)(15 - i) * 512), b = *(const f32x4*)(sp + (size_t)(15 - i) * 512 + 4);
#pragma unroll
                    for (int e = 0; e < 4; ++e) { s[e] += a[e]; s[4 + e] += b[e]; } }
                const float inv = 1.0f / (float)w; float d[8];
#pragma unroll
                for (int e = 0; e < 8; ++e) d[e] = s[e] * inv - cur[e];
                u32x4 o; o.x = cvt_pk_bf16(d[0], d[1]); o.y = cvt_pk_bf16(d[2], d[3]); o.z = cvt_pk_bf16(d[4], d[5]); o.w = cvt_pk_bf16(d[6], d[7]);
                *(LAS u32x4*)(Dm + n * 136 + ch8 * 8) = o;
                float* o2 = out + O_PS + (size_t)n * 15 * 512 + g * 128 + ch8 * 8;
                for (int i = 0; i < 14; ++i) { *(f32x4*)(o2 + (size_t)i * 512) = *(const f32x4*)(sp + (size_t)(i + 1) * 512); *(f32x4*)(o2 + (size_t)i * 512 + 4) = *(const f32x4*)(sp + (size_t)(i + 1) * 512 + 4); }
                *(f32x4*)(o2 + 14 * 512) = (f32x4){cur[0], cur[1], cur[2], cur[3]}; *(f32x4*)(o2 + 14 * 512 + 4) = (f32x4){cur[4], cur[5], cur[6], cur[7]}; }
        }
        __syncthreads();
        f32x4 acc[8];
#pragma unroll
        for (int nt = 0; nt < 8; ++nt) acc[nt] = (f32x4){0.f, 0.f, 0.f, 0.f};
#pragma unroll
        for (int kk = 0; kk < 4; ++kk) { const bf16x8 bfr = *(const LAS bf16x8*)(Dm + (16 * wave + fr) * 136 + 32 * kk + 8 * fq);
#pragma unroll
            for (int nt = 0; nt < 8; ++nt) { const bf16x8 afr = *(const bf16x8*)(WPT + (size_t)(g * 128 + 16 * nt + fr) * 128 + 32 * kk + 8 * fq);
                acc[nt] = __builtin_amdgcn_mfma_f32_16x16x32_bf16(afr, bfr, acc[nt], 0, 0, 0); } }
        const int row = t0 + 16 * wave + fr;
#pragma unroll
        for (int nt = 0; nt < 8; ++nt) { const int col = g * 128 + 16 * nt + 4 * fq; const f32x4 sc = *(const f32x4*)(P.pool_scale + col); const f32x4 o = acc[nt] * sc;
            u32x2 wv; wv.x = cvt_pk_bf16(o[0], o[1]); wv.y = cvt_pk_bf16(o[2], o[3]); *(u32x2*)(MIX + (size_t)row * DM + col) = wv; }
        __syncthreads();
    }
}

__device__ __forceinline__ void p4b_fix(const Params& P) {
    unsigned char* ws = P.ws; const float* upb = (const float*)(ws + WS_UPB); bf16_t* act = (bf16_t*)(ws + WS_ACT);
    const int gt = blockIdx.x * 512 + threadIdx.x, NGT = gridDim.x * 512;
    for (int i = gt; i < 64 * 2 * DFF; i += NGT) { const int ch = i % DFF, pr = i / DFF, pm = pr >> 1, r = pr & 1; const bool first = (pm & 7) == 0;
        float cv[2];
#pragma unroll
        for (int bj = 0; bj < 2; ++bj) { const int col = bj * DFF + ch; float p2, p1, cur;
            const float a0 = upb[(size_t)(pm * 4 + 0) * NUP + col];
            if (r == 0) { cur = a0; p1 = first ? 0.f : upb[(size_t)((pm - 1) * 4 + 3) * NUP + col]; p2 = first ? 0.f : upb[(size_t)((pm - 1) * 4 + 2) * NUP + col]; }
            else { cur = upb[(size_t)(pm * 4 + 1) * NUP + col]; p1 = a0; p2 = first ? 0.f : upb[(size_t)((pm - 1) * 4 + 3) * NUP + col]; }
            cv[bj] = P.ffn_conv_w[col] * p2 + P.ffn_conv_w[NUP + col] * p1 + P.ffn_conv_w[2 * NUP + col] * cur + P.ffn_conv_b[col]; }
        const float o = cv[0] * sigmoidf_(cv[0]) * cv[1];
        act[(size_t)(pm * 256 + r) * DFF + ch] = (bf16_t)(cvt_pk_bf16(o, 0.f) & 0xffffu); }
    for (int i = gt; i < 8 * 2 * NUP; i += NGT) { const int col = i % NUP, bj2 = i / NUP, b = bj2 >> 1, j = bj2 & 1;
        P.out[O_FP + i] = upb[(size_t)((8 * b + 7) * 4 + 2 + j) * NUP + col]; }
}

__device__ __forceinline__ void p7_final(const Params& P) {
    const int lane = threadIdx.x & 63, gw = blockIdx.x * 8 + (threadIdx.x >> 6), NGW = gridDim.x * 8;
    f32x4 gf[4];
#pragma unroll
    for (int j = 0; j < 4; ++j) gf[j] = ((const f32x4*)P.g_final)[64 * j + lane];
    for (int row = gw; row < MV; row += NGW) { f32x4* x4 = (f32x4*)(P.out + (size_t)row * DM) + lane; f32x4 v[4]; float s = 0.f;
#pragma unroll
        for (int j = 0; j < 4; ++j) { v[j] = x4[64 * j]; s += (v[j][0] * v[j][0] + v[j][1] * v[j][1]) + (v[j][2] * v[j][2] + v[j][3] * v[j][3]); }
        const float rs = rsqrtf(wave_sum(s) * (1.0f / DM) + EPS);
#pragma unroll
        for (int j = 0; j < 4; ++j) x4[64 * j] = v[j] * rs * gf[j]; }
}

constexpr int LDS_BYTES = pg8::STAGE_BYTES + 8192 + 16;
#ifndef REP0
#define REP0 1
#endif
#ifndef REP1
#define REP1 1
#endif
#ifndef REP2
#define REP2 1
#endif
#ifndef REP3
#define REP3 1
#endif
#ifndef REP4
#define REP4 1
#endif
#ifndef REPS
#define REPS 1
#endif

__global__ void __launch_bounds__(512, 2) fwd_kernel(Params P) {
    extern __shared__ __attribute__((aligned(16))) unsigned char lds_raw[];
    LAS unsigned char* lds = (LAS unsigned char*)lds_raw;
    unsigned char* ws = P.ws;
    if (P.ph_hi < 0) cg::this_grid().sync();
    volatile LAS unsigned* bst = (volatile LAS unsigned*)(lds + LDS_BYTES - 16);
    if (threadIdx.x < 4) bst[threadIdx.x] = 0u;
    __syncthreads();
    XcdBarrier bar = xcd_barrier_post((unsigned*)(ws + WS_BAR), bst);
    const int lo = P.ph_lo, hi = P.ph_hi;
#define IN(k) (lo <= (k) && (k) < hi)
#define SEAM(k) do { if (IN(k) && IN((k) + 1)) for (int rep_ = 0; rep_ < REPS; ++rep_) xcd_barrier(bar); } while (0)
    const int G = gridDim.x, bx = blockIdx.x;
    bf16_t* RB = (bf16_t*)(ws + WS_RB);
    if (IN(0)) for (int rep = 0; rep < REP0; ++rep) p0_prep(P, lds);
    SEAM(0);
    if (IN(1)) for (int rep = 0; rep < REP1; ++rep) {
        if (bx < 128) {
            const f32x4 a = sgemm_piece(lds, (const bf16_t*)(ws + WS_XB) + (size_t)TP * DM, (const bf16_t*)(ws + WS_WIN), DM, 16 * bx);
            const int r = threadIdx.x >> 2, c = 16 * bx + 4 * (threadIdx.x & 3); const float rs = ((const float*)(ws + WS_RSTD1))[TP + r];
            u32x2 w; w.x = cvt_pk_bf16(a[0] * rs, a[1] * rs); w.y = cvt_pk_bf16(a[2] * rs, a[3] * rs); *(u32x2*)((bf16_t*)(ws + WS_PROJ) + (size_t)(TP + r) * NINC + c) = w; }
        pg8::Gemm g{(const bf16_t*)(ws + WS_XB), (const bf16_t*)(ws + WS_WIN), TP, NINC, DM}; pg8::StaticOrder S; S.init(TP, NINC, G, bx);
        EpiScaleBf16 E{(bf16_t*)(ws + WS_PROJ), NINC, (const float*)(ws + WS_RSTD1)}; pg8::gemm_phase(lds, g, S, E); }
    SEAM(1);
    if (IN(2)) for (int rep = 0; rep < REP2; ++rep) p2_mix(P, lds);
    SEAM(2);
    if (IN(3)) for (int rep = 0; rep < REP3; ++rep) {
        if (bx < 64) {
            const f32x4 a = sgemm_piece(lds, (const bf16_t*)(ws + WS_MIX) + (size_t)TP * DM, (const bf16_t*)(ws + WS_WOUT), DM, 16 * bx);
            const int r = threadIdx.x >> 2, c = 16 * bx + 4 * (threadIdx.x & 3); const f32x4 o = *(const f32x4*)(P.x_sample + (size_t)r * DM + c) + a;
            *(f32x4*)(P.out + (size_t)(TP + r) * DM + c) = o; u32x2 w; w.x = cvt_pk_bf16(o[0], o[1]); w.y = cvt_pk_bf16(o[2], o[3]); *(u32x2*)(RB + (size_t)(TP + r) * DM + c) = w;
            float ss = (o[0] * o[0] + o[1] * o[1]) + (o[2] * o[2] + o[3] * o[3]); ss += __shfl_xor(ss, 1); ss += __shfl_xor(ss, 2);
            if ((threadIdx.x & 3) == 0) ((float*)(ws + WS_SSQ2S))[r * 64 + bx] = ss; }
        pg8::Gemm g{(const bf16_t*)(ws + WS_MIX), (const bf16_t*)(ws + WS_WOUT), TP, DM, DM}; pg8::StaticOrder S; S.init(TP, DM, G, bx);
        EpiRes E{P.x_prompt, P.x_sample, P.out, RB, (float*)(ws + WS_SSQ2)}; pg8::gemm_phase(lds, g, S, E); }
    SEAM(3);
    if (IN(4)) for (int rep = 0; rep < REP4; ++rep) { pg8::Gemm g{RB, (const bf16_t*)(ws + WS_WUP), MPAD, NUP, DM};
        { pg8::StaticOrder S; S.init(TP, NUP, G, bx);
          EpiUp<false> E{(const float*)(ws + WS_SSQ2), P.ffn_conv_w, P.ffn_conv_b, P.state_ffn, P.out + O_FS, (bf16_t*)(ws + WS_ACT), (float*)(ws + WS_UPB)}; pg8::gemm_phase(lds, g, S, E); }
        { pg8::StaticOrder S; S.init(256, NUP, G, (bx + G / 2) % G, 64);
          EpiUp<true> E{(const float*)(ws + WS_SSQ2S), P.ffn_conv_w, P.ffn_conv_b, P.state_ffn, P.out + O_FS, (bf16_t*)(ws + WS_ACT), (float*)(ws + WS_UPB)}; pg8::gemm_phase(lds, g, S, E); } }
    SEAM(4);
    if (IN(5)) p4b_fix(P);
    SEAM(5);
    if (IN(6)) {
        if (bx < 64) {
            const f32x4 a = sgemm_piece(lds, (const bf16_t*)(ws + WS_ACT) + (size_t)TP * DFF, (const bf16_t*)(ws + WS_WDOWN), DFF, 16 * bx);
            const int r = threadIdx.x >> 2, c = 16 * bx + 4 * (threadIdx.x & 3); float* op = P.out + (size_t)(TP + r) * DM + c; const f32x4 o = *(const f32x4*)op + a;
            *(f32x4*)op = o; u32x2 w; w.x = cvt_pk_bf16(o[0], o[1]); w.y = cvt_pk_bf16(o[2], o[3]); *(u32x2*)(RB + (size_t)(TP + r) * DM + c) = w;
            float ss = (o[0] * o[0] + o[1] * o[1]) + (o[2] * o[2] + o[3] * o[3]); ss += __shfl_xor(ss, 1); ss += __shfl_xor(ss, 2);
            if ((threadIdx.x & 3) == 0) ((float*)(ws + WS_SSQ3S))[r * 64 + bx] = ss;
        } else if (bx < 128) {
            const int pc = bx - 64;
            const f32x4 a = sgemm_piece(lds, (const bf16_t*)(ws + WS_PB) + (size_t)TP * PLE, (const bf16_t*)(ws + WS_WP), PLE, 16 * pc);
            const int r = threadIdx.x >> 2, c = 16 * pc + 4 * (threadIdx.x & 3);
            u32x2 w; w.x = cvt_pk_bf16(a[0], a[1]); w.y = cvt_pk_bf16(a[2], a[3]); *(u32x2*)((bf16_t*)(ws + WS_PP) + (size_t)(TP + r) * DM + c) = w; }
        { pg8::Gemm g{(const bf16_t*)(ws + WS_ACT), (const bf16_t*)(ws + WS_WDOWN), TP, DM, DFF}; pg8::StaticOrder S; S.init(TP, DM, G, bx);
          EpiRes E{P.out, P.out + (size_t)TP * DM, P.out, RB, (float*)(ws + WS_SSQ3)}; pg8::gemm_phase(lds, g, S, E); }
        { pg8::Gemm g{(const bf16_t*)(ws + WS_PB), (const bf16_t*)(ws + WS_WP), TP, DM, PLE}; pg8::StaticOrder S; S.init(TP, DM, G, bx);
          EpiScaleBf16 E{(bf16_t*)(ws + WS_PP), DM, nullptr}; pg8::gemm_phase(lds, g, S, E); }
    }
    SEAM(6);
    if (IN(7)) {
        if (bx < 64) {
            const f32x4 a = sgemm_piece(lds, RB + (size_t)TP * DM, (const bf16_t*)(ws + WS_WG), DM, 16 * bx);
            const int r = threadIdx.x >> 2, c = 16 * bx + 4 * (threadIdx.x & 3); float* op = P.out + (size_t)(TP + r) * DM + c;
            const float rs = rstd_s64((const float*)(ws + WS_SSQ3S), r); const f32x4 r2 = *(const f32x4*)op; const u32x2 pw = *(const u32x2*)((const bf16_t*)(ws + WS_PP) + (size_t)(TP + r) * DM + c);
            f32x4 o; o[0] = r2[0] + sigmoidf_(a[0] * rs) * bf_lo(pw.x); o[1] = r2[1] + sigmoidf_(a[1] * rs) * bf_hi(pw.x); o[2] = r2[2] + sigmoidf_(a[2] * rs) * bf_lo(pw.y); o[3] = r2[3] + sigmoidf_(a[3] * rs) * bf_hi(pw.y);
            *(f32x4*)op = o; }
        pg8::Gemm g{RB, (const bf16_t*)(ws + WS_WG), TP, DM, DM}; pg8::StaticOrder S; S.init(TP, DM, G, bx);
        EpiGate E{P.out, (const bf16_t*)(ws + WS_PP), (const float*)(ws + WS_SSQ3)}; pg8::gemm_phase(lds, g, S, E); }
    SEAM(7);
    if (IN(8)) p7_final(P);
#undef IN
#undef SEAM
}

extern "C" void kernel_launch(void* const* d_in, const int* in_sizes, int n_in, void* d_out, int out_size, void* d_ws, size_t ws_size, hipStream_t stream) {
    static int grid = 0;
    if (grid == 0) {
        int dev = 0, cus = 0, per_cu = 0;
        hipGetDevice(&dev);
        hipDeviceGetAttribute(&cus, hipDeviceAttributeMultiprocessorCount, dev);
        if (hipFuncSetAttribute((const void*)fwd_kernel, hipFuncAttributeMaxDynamicSharedMemorySize, LDS_BYTES) != hipSuccess) fprintf(stderr, "kernel_launch: hipFuncSetAttribute failed\n");
        if (hipOccupancyMaxActiveBlocksPerMultiprocessor(&per_cu, (const void*)fwd_kernel, 512, LDS_BYTES) != hipSuccess || per_cu < 1) { fprintf(stderr, "kernel_launch: occupancy query says %d\n", per_cu); per_cu = 1; }
        (void)hipGetLastError();
        grid = cus;
        if (ws_size < WS_END) fprintf(stderr, "kernel_launch: workspace too small: %zu < %zu\n", ws_size, (size_t)WS_END);
    }
    (void)hipMemsetAsync((unsigned char*)d_ws + WS_BAR, 0, XCD_BAR_WORDS * 4, stream);
    Params p{};
    const float* const* in = (const float* const*)d_in;
    p.x_prompt = in[0]; p.x_sample = in[1]; p.state_pool = in[2]; p.state_conv = in[3]; p.state_ffn = in[4]; p.p_prompt = in[5]; p.p_sample = in[6];
    p.g_mix = in[7]; p.w_in = in[8]; p.w_pool = in[9]; p.pool_scale = in[10]; p.conv_w = in[11]; p.conv_b = in[12]; p.w_out = in[13]; p.g_ffn = in[14]; p.w_up = in[15];
    p.ffn_conv_w = in[16]; p.ffn_conv_b = in[17]; p.w_down = in[18]; p.g_ple = in[19]; p.w_ple_gate = in[20]; p.w_ple_proj = in[21]; p.g_final = in[22];
    p.out = (float*)d_out; p.ws = (unsigned char*)d_ws; p.ph_lo = 0; p.ph_hi = 9;
    void* args[] = {&p};
    hipError_t e = hipLaunchCooperativeKernel((const void*)fwd_kernel, dim3(grid), dim3(512), args, LDS_BYTES, stream);
    if (e != hipSuccess) fprintf(stderr, "cooperative launch failed: %s (grid %d)\n", hipGetErrorString(e), grid);
}
```
